# Optimizing an MI355X kernel written in HIP

```python
import jax, jax.numpy as jnp
from jax import lax
import numpy as np

D_MODEL = 2048
BATCH = 2
SEQ = 4096
DEPTH = 1

CHUNK = 64
SG_WIDTH = 1024
SG_GROUPS = 4
SG_GROUP_DIM = SG_WIDTH // SG_GROUPS
SG_BLOCK = 128
ATT_HEADS = 8
ATT_HEAD_DIM = 128
ATT_WIDTH = ATT_HEADS * ATT_HEAD_DIM
LEFT_CHUNKS = 8
BAND = LEFT_CHUNKS + 1
REL_CLIP = 128
MEM_LEN = 256
MEM_HEADS = 4
MEM_HEAD_DIM = D_MODEL // MEM_HEADS
PEER_KEYS = 128
PEER_EXPERTS = PEER_KEYS * PEER_KEYS
PEER_HEADS = 8
PEER_QDIM = 256
PEER_HALF = PEER_QDIM // 2
PEER_TOPK = 16
PEER_BLOCK = 128

EPS = 1e-6
NEG_INF = -1e30
IN_SPLITS = [SG_WIDTH, 2 * SG_WIDTH, 2 * SG_WIDTH + ATT_WIDTH, 2 * SG_WIDTH + 2 * ATT_WIDTH,
             2 * SG_WIDTH + 3 * ATT_WIDTH, 2 * SG_WIDTH + 3 * ATT_WIDTH + D_MODEL]
IN_COLS = 2 * SG_WIDTH + 3 * ATT_WIDTH + 2 * D_MODEL

kernel_name = "hybrid_chunk_gmlp_relattn_peer"


def rmsnorm(x, g):
    xf = x.astype(jnp.float32)
    xf = xf * lax.rsqrt(jnp.mean(xf * xf, axis=-1, keepdims=True) + EPS)
    return xf.astype(x.dtype) * g


def layernorm(x, g, b):
    xf = x.astype(jnp.float32)
    mu = jnp.mean(xf, axis=-1, keepdims=True)
    var = jnp.mean(jnp.square(xf - mu), axis=-1, keepdims=True)
    return ((xf - mu) * lax.rsqrt(var + EPS)).astype(x.dtype) * g + b


def spatial_gating_mixer(z_u, z_v, ln_g, ln_b, w_s, b_s):
    B_, S_, _ = z_u.shape
    nb = S_ // SG_BLOCK
    v = layernorm(z_v, ln_g, ln_b).reshape(B_, nb, SG_BLOCK, SG_GROUPS, SG_GROUP_DIM)
    cpos = jnp.arange(SG_BLOCK) // CHUNK
    mask = (cpos[:, None] >= cpos[None, :]).astype(w_s.dtype)
    w = w_s * mask[None]
    s = jnp.einsum('gij,bnjgc->bnigc', w, v) + jnp.transpose(b_s)[:, :, None]
    return z_u * s.reshape(B_, S_, SG_WIDTH)


def chunked_relpos_attention(q, k, v, rel_bias):
    B_, S_, _ = q.shape
    nc = S_ // CHUNK

    def heads(t):
        return t.reshape(B_, nc, CHUNK, ATT_HEADS, ATT_HEAD_DIM)

    q, k, v = heads(q), heads(k), heads(v)
    pad = ((0, 0), (LEFT_CHUNKS, 0), (0, 0), (0, 0), (0, 0))
    kp, vp = jnp.pad(k, pad), jnp.pad(v, pad)
    k_band = jnp.concatenate([kp[:, w:w + nc] for w in range(BAND)], axis=2)
    v_band = jnp.concatenate([vp[:, w:w + nc] for w in range(BAND)], axis=2)
    scale = ATT_HEAD_DIM ** -0.5
    scores = jnp.einsum('bcqhd,bckhd->bhcqk', q, k_band).astype(jnp.float32) * scale
    qi = jnp.arange(CHUNK)
    kj = jnp.arange(BAND * CHUNK)
    dist = (LEFT_CHUNKS * CHUNK + qi[:, None]) - kj[None, :]
    idx = jnp.clip(dist, -REL_CLIP, REL_CLIP) + REL_CLIP
    bias = rel_bias[:, idx].astype(jnp.float32)
    scores = scores + bias[None, :, None]
    chunk_ids = jnp.arange(nc)
    valid = (chunk_ids[:, None] - LEFT_CHUNKS + (kj // CHUNK)[None, :]) >= 0
    scores = jnp.where(valid[None, None, :, None, :], scores, NEG_INF)
    p = jax.nn.softmax(scores, axis=-1).astype(v_band.dtype)
    o = jnp.einsum('bhcqk,bckhd->bcqhd', p, v_band)
    return o.reshape(B_, S_, ATT_WIDTH)


def memory_cross_attention(a, m, w_q, w_kv, w_o):
    B_, S_, _ = a.shape
    q = (a @ w_q).reshape(B_, S_, MEM_HEADS, MEM_HEAD_DIM)
    kv = m @ w_kv
    k = kv[..., :D_MODEL].reshape(B_, -1, MEM_HEADS, MEM_HEAD_DIM)
    v = kv[..., D_MODEL:].reshape(B_, -1, MEM_HEADS, MEM_HEAD_DIM)
    s = jnp.einsum('bshd,bmhd->bhsm', q, k).astype(jnp.float32) * (MEM_HEAD_DIM ** -0.5)
    p = jax.nn.softmax(s, axis=-1).astype(v.dtype)
    o = jnp.einsum('bhsm,bmhd->bshd', p, v).reshape(B_, S_, D_MODEL)
    return o @ w_o


def peer_ffn(a, w_pq, sub_keys, expert_u, expert_v):
    B_, S_, D = a.shape
    t = a.reshape(-1, D)
    T = t.shape[0]
    q = (t @ w_pq).reshape(T, PEER_HEADS, 2, PEER_HALF)
    s = jnp.einsum('thpd,pnd->thpn', q, sub_keys).astype(jnp.float32)
    top_s, top_i = lax.top_k(s, PEER_TOPK)
    cand = (top_s[:, :, 0, :, None] + top_s[:, :, 1, None, :]).reshape(T, PEER_HEADS, PEER_TOPK * PEER_TOPK)
    best_s, best_c = lax.top_k(cand, PEER_TOPK)
    i1 = jnp.take_along_axis(top_i[:, :, 0], best_c // PEER_TOPK, axis=-1)
    i2 = jnp.take_along_axis(top_i[:, :, 1], best_c % PEER_TOPK, axis=-1)
    expert = (i1 * PEER_KEYS + i2).astype(jnp.int32)
    gate = jax.nn.softmax(best_s, axis=-1).astype(t.dtype)
    nt = T // PEER_BLOCK

    def block(args):
        xb, eb, gb = args
        u = expert_u[eb]
        pre = jnp.einsum('bd,bed->be', xb, u)
        act = jax.nn.gelu(pre.astype(jnp.float32), approximate=False).astype(xb.dtype) * gb
        return jnp.einsum('be,bed->bd', act, expert_v[eb])

    out = lax.map(block, (t.reshape(nt, PEER_BLOCK, D),
                          expert.reshape(nt, PEER_BLOCK, PEER_HEADS * PEER_TOPK),
                          gate.reshape(nt, PEER_BLOCK, PEER_HEADS * PEER_TOPK)))
    return out.reshape(B_, S_, D)


def _normal(k, shape, std):
    return jax.random.normal(k, shape, jnp.float32) * std


def setup_inputs(seed: int = 0) -> dict:
    key = jax.random.key(seed)
    ks = jax.random.split(key, 23)
    L, D = DEPTH, D_MODEL
    return {
        "x": _normal(ks[0], (BATCH, SEQ, D), 1.0),
        "mem": _normal(ks[1], (BATCH, MEM_LEN, D), 1.0),
        "g_mix": 1.0 + _normal(ks[2], (L, D), 0.02),
        "w_in": _normal(ks[3], (L, D, IN_COLS), D ** -0.5),
        "sg_ln_g": 1.0 + _normal(ks[4], (L, SG_WIDTH), 0.02),
        "sg_ln_b": _normal(ks[5], (L, SG_WIDTH), 0.02),
        "sg_w_s": _normal(ks[6], (L, SG_GROUPS, SG_BLOCK, SG_BLOCK), 0.5 * SG_BLOCK ** -0.5),
        "sg_b_s": 1.0 + _normal(ks[7], (L, SG_GROUPS, SG_BLOCK), 0.02),
        "att_rel_bias": _normal(ks[8], (L, ATT_HEADS, 2 * REL_CLIP + 1), 0.5),
        "w_up_a": _normal(ks[9], (L, SG_WIDTH, D), SG_WIDTH ** -0.5),
        "w_up_b": _normal(ks[10], (L, ATT_WIDTH, D), ATT_WIDTH ** -0.5),
        "w_out": _normal(ks[11], (L, D, D), D ** -0.5),
        "g_mem_q": 1.0 + _normal(ks[12], (L, D), 0.02),
        "g_mem_kv": 1.0 + _normal(ks[13], (L, D), 0.02),
        "mem_w_q": _normal(ks[14], (L, D, D), D ** -0.5),
        "mem_w_kv": _normal(ks[15], (L, D, 2 * D), D ** -0.5),
        "mem_w_o": _normal(ks[16], (L, D, D), D ** -0.5),
        "g_ffn": 1.0 + _normal(ks[17], (L, D), 0.02),
        "peer_w_q": _normal(ks[18], (L, D, PEER_HEADS * PEER_QDIM), D ** -0.5),
        "peer_sub_keys": _normal(ks[19], (L, 2, PEER_KEYS, PEER_HALF), PEER_HALF ** -0.5),
        "peer_u": _normal(ks[20], (L, PEER_EXPERTS, D), D ** -0.5),
        "peer_v": _normal(ks[21], (L, PEER_EXPERTS, D), PEER_HEADS ** -0.5),
        "g_final": 1.0 + _normal(ks[22], (D,), 0.02),
    }


def reference(x, mem, g_mix, w_in, sg_ln_g, sg_ln_b, sg_w_s, sg_b_s, att_rel_bias, w_up_a, w_up_b, w_out,
              g_mem_q, g_mem_kv, mem_w_q, mem_w_kv, mem_w_o, g_ffn, peer_w_q, peer_sub_keys, peer_u, peer_v,
              g_final):
    h = x
    for l in range(DEPTH):
        a = rmsnorm(h, g_mix[l])
        z = a @ w_in[l]
        z_u, z_v, q, k, v, gate_a, gate_b = jnp.split(z, IN_SPLITS, axis=-1)
        y_a = spatial_gating_mixer(jax.nn.gelu(z_u, approximate=False), jax.nn.gelu(z_v, approximate=False),
                                   sg_ln_g[l], sg_ln_b[l], sg_w_s[l], sg_b_s[l])
        y_b = chunked_relpos_attention(q, k, v, att_rel_bias[l])
        merged = jax.nn.sigmoid(gate_a) * (y_a @ w_up_a[l]) + jax.nn.sigmoid(gate_b) * (y_b @ w_up_b[l])
        h = h + merged @ w_out[l]
        h = h + memory_cross_attention(rmsnorm(h, g_mem_q[l]), rmsnorm(mem, g_mem_kv[l]),
                                       mem_w_q[l], mem_w_kv[l], mem_w_o[l])
        h = h + peer_ffn(rmsnorm(h, g_ffn[l]), peer_w_q[l], peer_sub_keys[l], peer_u[l], peer_v[l])
    return rmsnorm(h, g_final)
```

```cpp
#include <hip/hip_runtime.h>
#include <cstdio>
#include <cstdint>
#define MK_N_LAUNCHES 1
namespace pg8 {
#define PG8_LAS __attribute__((address_space(3)))
typedef unsigned short bf16_t;
typedef short bf16x8 __attribute__((ext_vector_type(8)));
typedef float f32x4 __attribute__((ext_vector_type(4)));
typedef unsigned u32x4 __attribute__((ext_vector_type(4)));
constexpr int BM = 256, BK = 64, HALF = 128, HTB = HALF * BK * 2  , STAGE_BYTES = 8 * HTB, NXCD = 8, WGM = 8;

__host__ __device__ __forceinline__ int lds_byte(int r, int c) { const int st = (r >> 4) * 2 + (c >> 5), rr = r & 15, cc = c & 31, ob = rr * 64 + cc * 2; return st * 1024 + (ob ^ (((ob >> 9) & 1) << 5)); }
__host__ __device__ __forceinline__ void stage_rc(int b, int& R, int& C) { const int st = b / 1024, sb = b % 1024, swz = sb ^ (((sb >> 9) & 1) << 5); R = (st >> 1) * 16 + swz / 64; C = (st & 1) * 32 + (swz % 64) / 2; }
__host__ __device__ __forceinline__ int perm32(int rho) { const int n = rho >> 4, i = rho & 15; return 8 * (i >> 2) + 4 * n + (i & 3); }

struct Unit { int pm, pn; };
struct Gemm { const bf16_t* A; const bf16_t* Bt; int M, N, K; };

struct StaticOrder {
    int nM, nN, nwg, G, c;
    __host__ __device__ void init(int M, int N, int G_, int c_) { nM = M / BM; nN = N / BM; nwg = nM * nN; G = G_; c = c_; }
    __host__ __device__ bool next(int i, Unit& u) const {
        const long L = (long)i * G + c; if (L >= nwg) return false;
        int wgid = (int)L; { const int q = nwg / NXCD, r = nwg % NXCD, xcd = wgid % NXCD, off = wgid / NXCD; wgid = (xcd < r ? xcd * (q + 1) : r * (q + 1) + (xcd - r) * q) + off; }
        const int nig = WGM * nN, gid = wgid / nig, fm = gid * WGM, gsz = (nM - fm) < WGM ? (nM - fm) : WGM;
        u.pm = fm + ((wgid % nig) % gsz); u.pn = (wgid % nig) / gsz; return true;
    }
    __device__ __forceinline__ void a_ready(const Unit&) const {}
    __device__ __forceinline__ void done(const Unit&) const {}
};

typedef __bf16 bf16x2_cv __attribute__((ext_vector_type(2)));
typedef float f32x2_cv __attribute__((ext_vector_type(2)));
__device__ __forceinline__ unsigned cvt_pk_bf16(float lo, float hi) { const f32x2_cv v = {lo, hi}; const bf16x2_cv b = __builtin_convertvector(v, bf16x2_cv); return __builtin_bit_cast(unsigned, b); }
typedef float f32x2 __attribute__((ext_vector_type(2)));
__device__ __forceinline__ f32x2 gelu_pk(f32x2 v) {
    const f32x2 av = __builtin_elementwise_abs(v), d = av * 0.2316418882f + 1.0f;
    f32x2 t; t.x = __builtin_amdgcn_rcpf(d.x); t.y = __builtin_amdgcn_rcpf(d.y);
    f32x2 q = t * 0.5307027145f + (-0.7265760135f); q = q * t + 0.7107068705f; q = q * t + (-0.142248368f); q = q * t + 0.127414796f; q = q * t;
    const f32x2 s = (v * v) * (-0.72134752044f);
    f32x2 e; e.x = __builtin_amdgcn_exp2f(s.x); e.y = __builtin_amdgcn_exp2f(s.y);
    const f32x2 m = v * (q * e), r = v - m;
    f32x2 o; o.x = v.x < 0.f ? m.x : r.x; o.y = v.y < 0.f ? m.y : r.y; return o;
}
__device__ __forceinline__ float sigmoid1(float x) { return __builtin_amdgcn_rcpf(1.0f + __expf(-x)); }
__device__ __forceinline__ u32x4 pack8(const f32x4& v0, const f32x4& v1) { u32x4 w; w.x = cvt_pk_bf16(v0[0], v0[1]); w.y = cvt_pk_bf16(v0[2], v0[3]); w.z = cvt_pk_bf16(v1[0], v1[1]); w.w = cvt_pk_bf16(v1[2], v1[3]); return w; }
__device__ __forceinline__ float bf_lo(unsigned w) { return __builtin_bit_cast(float, w << 16); }
__device__ __forceinline__ float bf_hi(unsigned w) { return __builtin_bit_cast(float, w & 0xffff0000u); }
__device__ __forceinline__ void unpack8(const u32x4& w, f32x4& v0, f32x4& v1) { v0 = (f32x4){bf_lo(w.x), bf_hi(w.x), bf_lo(w.y), bf_hi(w.y)}; v1 = (f32x4){bf_lo(w.z), bf_hi(w.z), bf_lo(w.w), bf_hi(w.w)}; }

#ifndef DBG_NO_T1
#define DBG_NO_T1 0
#endif
#define PG8_THROTTLE() asm volatile("s_waitcnt vmcnt(24)" ::: "memory")
#define PG8_EPI_LOOP(...) \
    _Pragma("unroll") for (int ai = 0; ai < 2; ++ai) _Pragma("unroll") for (int m = 0; m < 4; ++m) { \
        const int row = u.pm * BM + ai * HALF + wr * 64 + m * 16 + fr; (void)row; \
        _Pragma("unroll") for (int bj = 0; bj < 2; ++bj) { \
            const int col = u.pn * BM + bj * HALF + wc * 32 + 8 * fq; (void)col; \
            f32x4 v0 = acc[ai][bj][m][0], v1 = acc[ai][bj][m][1]; __VA_ARGS__ } }

struct EpiIn {
    static constexpr bool PERM = true, AFTER_DRAIN = false, MIDHOOK = false;
    bf16_t* ZU;
    bf16_t* ZVT;
    bf16_t* QK;
    bf16_t* VT;
    bf16_t* GAB;
    float qscale;
    __device__ __forceinline__ void operator()(const f32x4 (&acc)[2][2][4][2], const Unit& u, int wr, int wc, int fr, int fq) const {
        const int pn = u.pn;
        if (pn < 4) {
            PG8_EPI_LOOP({ f32x2 a = gelu_pk((f32x2){v0[0], v0[1]}), b = gelu_pk((f32x2){v0[2], v0[3]}), c = gelu_pk((f32x2){v1[0], v1[1]}), d = gelu_pk((f32x2){v1[2], v1[3]});
                v0 = (f32x4){a.x, a.y, b.x, b.y}; v1 = (f32x4){c.x, c.y, d.x, d.y};
                *(u32x4*)(ZU + (size_t)row * 1024 + col) = pack8(v0, v1); })
        } else if (pn < 8) {
            PG8_EPI_LOOP({ f32x2 a = gelu_pk((f32x2){v0[0], v0[1]}), b = gelu_pk((f32x2){v0[2], v0[3]}), c = gelu_pk((f32x2){v1[0], v1[1]}), d = gelu_pk((f32x2){v1[2], v1[3]});
                const u32x4 w = pack8((f32x4){a.x, a.y, b.x, b.y}, (f32x4){c.x, c.y, d.x, d.y});
                bf16_t* p = ZVT + ((size_t)(row >> 7) * 1024 + (col - 1024)) * 128 + (row & 127);
                p[0 * 128] = (bf16_t)(w.x & 0xffffu); p[1 * 128] = (bf16_t)(w.x >> 16); p[2 * 128] = (bf16_t)(w.y & 0xffffu); p[3 * 128] = (bf16_t)(w.y >> 16);
                p[4 * 128] = (bf16_t)(w.z & 0xffffu); p[5 * 128] = (bf16_t)(w.z >> 16); p[6 * 128] = (bf16_t)(w.w & 0xffffu); p[7 * 128] = (bf16_t)(w.w >> 16); PG8_THROTTLE(); })
        } else if (pn < 16) {
            const float sc = pn < 12 ? qscale : 1.0f;
            PG8_EPI_LOOP({ v0 = v0 * sc; v1 = v1 * sc; *(u32x4*)(QK + (size_t)row * 2048 + (col - 2048)) = pack8(v0, v1); })
        } else if (pn < 20) {
            PG8_EPI_LOOP({ const u32x4 w = pack8(v0, v1); const int c = col - 4096;
                bf16_t* p = VT + ((size_t)((row >> 12) * 1024 + c)) * 4096 + (row & 4095);
                p[0 * 4096] = (bf16_t)(w.x & 0xffffu); p[1 * 4096] = (bf16_t)(w.x >> 16); p[2 * 4096] = (bf16_t)(w.y & 0xffffu); p[3 * 4096] = (bf16_t)(w.y >> 16);
                p[4 * 4096] = (bf16_t)(w.z & 0xffffu); p[5 * 4096] = (bf16_t)(w.z >> 16); p[6 * 4096] = (bf16_t)(w.w & 0xffffu); p[7 * 4096] = (bf16_t)(w.w >> 16); PG8_THROTTLE(); })
        } else {
            PG8_EPI_LOOP({ v0 = (f32x4){sigmoid1(v0[0]), sigmoid1(v0[1]), sigmoid1(v0[2]), sigmoid1(v0[3])}; v1 = (f32x4){sigmoid1(v1[0]), sigmoid1(v1[1]), sigmoid1(v1[2]), sigmoid1(v1[3])};
                *(u32x4*)(GAB + (size_t)row * 4096 + (col - 5120)) = pack8(v0, v1); })
        }
    }
};
struct EpiKV {
    static constexpr bool PERM = true, AFTER_DRAIN = false, MIDHOOK = false;
    bf16_t* KM;
    bf16_t* VTM;
    __device__ __forceinline__ void operator()(const f32x4 (&acc)[2][2][4][2], const Unit& u, int wr, int wc, int fr, int fq) const {
        if (u.pn < 8) {
            PG8_EPI_LOOP({ *(u32x4*)(KM + (size_t)row * 2048 + col) = pack8(v0, v1); })
        } else {
            PG8_EPI_LOOP({ const u32x4 w = pack8(v0, v1); const int c = col - 2048;
                bf16_t* p = VTM + ((size_t)((row >> 8) * 2048 + c)) * 256 + (row & 255);
                p[0 * 256] = (bf16_t)(w.x & 0xffffu); p[1 * 256] = (bf16_t)(w.x >> 16); p[2 * 256] = (bf16_t)(w.y & 0xffffu); p[3 * 256] = (bf16_t)(w.y >> 16);
                p[4 * 256] = (bf16_t)(w.z & 0xffffu); p[5 * 256] = (bf16_t)(w.z >> 16); p[6 * 256] = (bf16_t)(w.w & 0xffffu); p[7 * 256] = (bf16_t)(w.w >> 16); PG8_THROTTLE(); })
        }
    }
};
template <bool FIRST> struct EpiUp {
    static constexpr bool PERM = true, AFTER_DRAIN = false, MIDHOOK = false;
    const bf16_t* GAB; bf16_t* T1; bf16_t* MRG;
    __device__ __forceinline__ void mid(f32x4 (&)[2][2][4][2], const Unit&, int, int, int, int) const {}
    __device__ __forceinline__ void operator()(const f32x4 (&acc)[2][2][4][2], const Unit& u, int wr, int wc, int fr, int fq) const {
        PG8_EPI_LOOP({ f32x4 g0, g1; unpack8(*(const u32x4*)(GAB + (size_t)row * 4096 + (FIRST ? 0 : 2048) + col), g0, g1);
            v0 = v0 * g0; v1 = v1 * g1;
            if (FIRST) { *(u32x4*)(T1 + (size_t)row * 2048 + col) = pack8(v0, v1); }
            else { f32x4 t0, t1; unpack8(*(const u32x4*)(T1 + (size_t)row * 2048 + col), t0, t1); v0 = v0 + t0; v1 = v1 + t1; *(u32x4*)(MRG + (size_t)row * 2048 + col) = pack8(v0, v1); } })
    }
};
struct EpiRes {
    static constexpr bool PERM = true, AFTER_DRAIN = false, MIDHOOK = false;
    const float* base; float* H; bf16_t* AN; const float* gain; float* PS;
    __device__ __forceinline__ void operator()(const f32x4 (&acc)[2][2][4][2], const Unit& u, int wr, int wc, int fr, int fq) const {
#pragma unroll
        for (int ai = 0; ai < 2; ++ai)
#pragma unroll
            for (int m = 0; m < 4; ++m) {
                const int row = u.pm * BM + ai * HALF + wr * 64 + m * 16 + fr; float ss = 0.f;
#pragma unroll
                for (int bj = 0; bj < 2; ++bj) { const int col = u.pn * BM + bj * HALF + wc * 32 + 8 * fq; const size_t off = (size_t)row * 2048 + col;
                    const f32x4 b0 = *(const f32x4*)(base + off), b1 = *(const f32x4*)(base + off + 4);
                    const f32x4 g0 = *(const f32x4*)(gain + col), g1 = *(const f32x4*)(gain + col + 4);
                    const f32x4 h0 = acc[ai][bj][m][0] + b0, h1 = acc[ai][bj][m][1] + b1;
                    *(f32x4*)(H + off) = h0; *(f32x4*)(H + off + 4) = h1;
                    ss += (h0[0] * h0[0] + h0[1] * h0[1]) + (h0[2] * h0[2] + h0[3] * h0[3]) + (h1[0] * h1[0] + h1[1] * h1[1]) + (h1[2] * h1[2] + h1[3] * h1[3]);
                    *(u32x4*)(AN + off) = pack8(h0 * g0, h1 * g1); }
                ss += __shfl_xor(ss, 16); ss += __shfl_xor(ss, 32);
                if (fq == 0) PS[(size_t)row * 32 + u.pn * 4 + wc] = ss;
            }
    }
};
struct EpiRowScale {
    static constexpr bool PERM = true, AFTER_DRAIN = false, MIDHOOK = false;
    const float* PS; bf16_t* O; float scale, eps;
    __device__ __forceinline__ void operator()(const f32x4 (&acc)[2][2][4][2], const Unit& u, int wr, int wc, int fr, int fq) const {
#pragma unroll
        for (int ai = 0; ai < 2; ++ai)
#pragma unroll
            for (int m = 0; m < 4; ++m) {
                const int row = u.pm * BM + ai * HALF + wr * 64 + m * 16 + fr; const f32x4* ps = (const f32x4*)(PS + (size_t)row * 32); float s = 0.f;
#pragma unroll
                for (int i = 0; i < 8; ++i) { const f32x4 t = ps[i]; s += (t[0] + t[1]) + (t[2] + t[3]); }
                const float rs = __builtin_amdgcn_rsqf(s * (1.0f / 2048.0f) + eps) * scale;
#pragma unroll
                for (int bj = 0; bj < 2; ++bj) { const int col = u.pn * BM + bj * HALF + wc * 32 + 8 * fq;
                    *(u32x4*)(O + (size_t)row * 2048 + col) = pack8(acc[ai][bj][m][0] * rs, acc[ai][bj][m][1] * rs); }
            }
    }
};
struct EpiPlain {
    static constexpr bool PERM = true, AFTER_DRAIN = false, MIDHOOK = false;
    bf16_t* O; int ldc;
    __device__ __forceinline__ void operator()(const f32x4 (&acc)[2][2][4][2], const Unit& u, int wr, int wc, int fr, int fq) const {
        PG8_EPI_LOOP({ *(u32x4*)(O + (size_t)row * ldc + col) = pack8(v0, v1); })
    }
};
struct ShiftedOrder {
    StaticOrder S; bool on;
    __host__ __device__ void init(int M, int N, int G_, int c_, int first) { on = c_ >= first; S.init(M, N, G_, on ? c_ - first : 0); }
    __host__ __device__ bool next(int i, Unit& u) const { return on && S.next(i, u); }
    __device__ __forceinline__ void a_ready(const Unit&) const {}
    __device__ __forceinline__ void done(const Unit&) const {}
};

template <class Epi, class Sched, bool ALIGN_EPI = false, bool SP2 = false>
__device__ __forceinline__ void gemm_phase(PG8_LAS unsigned char* lds, const Gemm g, const Sched& S, const Epi& E) {
    const int tid = threadIdx.x, wid = __builtin_amdgcn_readfirstlane(tid >> 6), lane = tid & 63, wr = wid >> 2, wc = wid & 3, fr = lane & 15, fq = lane >> 4;
    const int K = g.K, nt = K / BK;
    unsigned voffA[2], voffB[2];
#pragma unroll
    for (int i = 0; i < 2; ++i) { int R, C; stage_rc(tid * 16 + i * 8192, R, C); const int Rb = Epi::PERM ? ((R & ~31) + perm32(R & 31)) : R;
        voffA[i] = (unsigned)(R * K + C) * 2u; voffB[i] = (unsigned)(Rb * K + C) * 2u; }
    const size_t kstep = (size_t)(BK * 2);
    const size_t hstep = (size_t)HALF * K * 2;
    const size_t tstep = 2 * hstep;
    const unsigned ldsw = (unsigned)wid * 1024u;
    const int aoff = lds_byte(wr * 64 + fr, fq * 8), boff = lds_byte(wc * 32 + fr, fq * 8);
#define PG8_SA(b, h) (((b) * 2 + (h)) * HTB)
#define PG8_SB(b, h) ((4 + (b) * 2 + (h)) * HTB)
#define PG8_STAGE(bufoff, gbase, voff) do { _Pragma("unroll") for (int _i = 0; _i < 2; ++_i) \
        __builtin_amdgcn_global_load_lds((const unsigned*)((const char*)(gbase) + (voff)[_i]), (PG8_LAS unsigned*)(lds + (bufoff) + ldsw + _i * 8192), 16, 0, 0); } while (0)
#define PG8_LDA(dst, b, h) do { _Pragma("unroll") for (int m = 0; m < 4; ++m) _Pragma("unroll") for (int k = 0; k < 2; ++k) dst[m][k] = *(const PG8_LAS bf16x8*)(lds + PG8_SA(b, h) + aoff + m * 2048 + k * 1024); } while (0)
#define PG8_LDB(dst, b, h) do { _Pragma("unroll") for (int n = 0; n < 2; ++n) _Pragma("unroll") for (int k = 0; k < 2; ++k) dst[n][k] = *(const PG8_LAS bf16x8*)(lds + PG8_SB(b, h) + boff + n * 2048 + k * 1024); } while (0)
#define PG8_MMA(ai, bj, At, Bt) do { __builtin_amdgcn_s_setprio(1); _Pragma("unroll") for (int m = 0; m < 4; ++m) _Pragma("unroll") for (int n = 0; n < 2; ++n) _Pragma("unroll") for (int k = 0; k < 2; ++k) \
        acc[ai][bj][m][n] = __builtin_amdgcn_mfma_f32_16x16x32_bf16(Bt[n][k], At[m][k], acc[ai][bj][m][n], 0, 0, 0); __builtin_amdgcn_s_setprio(0); } while (0)
#define PG8_WAIT_V(n) asm volatile("s_waitcnt vmcnt(" #n ")" ::: "memory")
#define PG8_WAIT_L(n) asm volatile("s_waitcnt lgkmcnt(" #n ")" ::: "memory")
#define PG8_BAR __builtin_amdgcn_s_barrier()
#define PG8_SCHED __builtin_amdgcn_sched_barrier(0)
    Unit cur, nxt; int ui = 0;
    if (!S.next(0, cur)) return;
    f32x4 acc[2][2][4][2];
#pragma unroll
    for (int a = 0; a < 2; ++a)
#pragma unroll
        for (int b = 0; b < 2; ++b)
#pragma unroll
            for (int m = 0; m < 4; ++m)
#pragma unroll
                for (int n = 0; n < 2; ++n) acc[a][b][m][n] = (f32x4){0.f, 0.f, 0.f, 0.f};
    bf16x8 At[4][2], B0[2][2], B1[2][2];
    const char* cA = (const char*)g.A + (size_t)cur.pm * tstep; const char* cB = (const char*)g.Bt + (size_t)cur.pn * tstep;
    S.a_ready(cur);
    if constexpr (SP2) {
        PG8_STAGE(PG8_SB(0, 0), cB, voffB); PG8_STAGE(PG8_SB(0, 1), cB + hstep, voffB); PG8_STAGE(PG8_SA(0, 0), cA, voffA); PG8_STAGE(PG8_SA(0, 1), cA + hstep, voffA);
        if (wr == 1) PG8_BAR;
        PG8_WAIT_V(2); PG8_BAR;
        PG8_STAGE(PG8_SB(1, 0), cB + kstep, voffB); PG8_STAGE(PG8_SA(1, 0), cA + kstep, voffA); PG8_STAGE(PG8_SB(1, 1), cB + hstep + kstep, voffB);
        PG8_WAIT_V(6); PG8_BAR;
    } else {
        PG8_STAGE(PG8_SB(0, 0), cB, voffB); PG8_STAGE(PG8_SA(0, 0), cA, voffA); PG8_STAGE(PG8_SB(0, 1), cB + hstep, voffB); PG8_STAGE(PG8_SA(0, 1), cA + hstep, voffA);
        if (wr == 1) PG8_BAR;
        PG8_WAIT_V(4); PG8_BAR;
        PG8_STAGE(PG8_SB(1, 0), cB + kstep, voffB); PG8_STAGE(PG8_SA(1, 0), cA + kstep, voffA); PG8_STAGE(PG8_SB(1, 1), cB + hstep + kstep, voffB);
        PG8_WAIT_V(6); PG8_BAR;
    }
    for (;;) {
        const bool has_next = S.next(ui + 1, nxt);
        const char* nA = has_next ? (const char*)g.A + (size_t)nxt.pm * tstep : cA; const char* nB = has_next ? (const char*)g.Bt + (size_t)nxt.pn * tstep : cB;
        for (int t = 0; t < nt; t += 2) {
            const bool last = (t == nt - 2);
            const char* a1 = cA + (size_t)(t + 1) * kstep;
            const char* a2 = last ? nA : cA + (size_t)(t + 2) * kstep; const char* b2 = last ? nB : cB + (size_t)(t + 2) * kstep;
            const char* a3 = a2 + kstep; const char* b3 = b2 + kstep;
            if (last && has_next) S.a_ready(nxt);
            if constexpr (SP2) {
            PG8_LDB(B0, 0, 0); PG8_LDB(B1, 0, 1); PG8_SCHED; PG8_LDA(At, 0, 0); PG8_STAGE(PG8_SA(1, 1), a1 + hstep, voffA);
            PG8_WAIT_V(8); PG8_WAIT_L(0); PG8_BAR; PG8_MMA(0, 0, At, B0); PG8_MMA(0, 1, At, B1); PG8_BAR; PG8_SCHED;
            PG8_LDA(At, 0, 1); PG8_STAGE(PG8_SB(0, 0), b2, voffB); PG8_STAGE(PG8_SB(0, 1), b2 + hstep, voffB); PG8_STAGE(PG8_SA(0, 0), a2, voffA);
            PG8_WAIT_V(8); PG8_WAIT_L(0); PG8_BAR; PG8_MMA(1, 0, At, B0); PG8_MMA(1, 1, At, B1); PG8_BAR; PG8_SCHED;
            PG8_LDB(B0, 1, 0); PG8_LDB(B1, 1, 1); PG8_SCHED; PG8_LDA(At, 1, 0); PG8_STAGE(PG8_SA(0, 1), a2 + hstep, voffA);
            PG8_WAIT_V(8); PG8_WAIT_L(0); PG8_BAR; PG8_MMA(0, 0, At, B0); PG8_MMA(0, 1, At, B1); PG8_BAR; PG8_SCHED;
            PG8_LDA(At, 1, 1); PG8_STAGE(PG8_SB(1, 0), b3, voffB); PG8_STAGE(PG8_SB(1, 1), b3 + hstep, voffB); PG8_STAGE(PG8_SA(1, 0), a3, voffA);
            PG8_WAIT_V(8); PG8_WAIT_L(0); PG8_BAR; PG8_MMA(1, 0, At, B0); PG8_MMA(1, 1, At, B1); PG8_BAR; PG8_SCHED;
            } else {
            PG8_LDB(B0, 0, 0); PG8_SCHED; PG8_LDA(At, 0, 0); PG8_STAGE(PG8_SA(1, 1), a1 + hstep, voffA);
            PG8_WAIT_L(8); PG8_BAR; PG8_WAIT_L(0); PG8_MMA(0, 0, At, B0); PG8_BAR; PG8_SCHED;
            PG8_LDB(B1, 0, 1); PG8_STAGE(PG8_SB(0, 0), b2, voffB);
            PG8_BAR; PG8_WAIT_L(0); PG8_MMA(0, 1, At, B1); PG8_BAR;
            PG8_LDA(At, 0, 1); PG8_STAGE(PG8_SA(0, 0), a2, voffA);
            PG8_BAR; PG8_WAIT_L(0); PG8_MMA(1, 0, At, B0); PG8_BAR; PG8_SCHED;
            PG8_STAGE(PG8_SB(0, 1), b2 + hstep, voffB);
            PG8_WAIT_V(6); PG8_BAR; PG8_MMA(1, 1, At, B1); PG8_BAR;
            PG8_LDB(B0, 1, 0); PG8_SCHED; PG8_LDA(At, 1, 0); PG8_STAGE(PG8_SA(0, 1), a2 + hstep, voffA);
            PG8_WAIT_L(8); PG8_BAR; PG8_WAIT_L(0); PG8_MMA(0, 0, At, B0); PG8_BAR; PG8_SCHED;
            PG8_LDB(B1, 1, 1); PG8_STAGE(PG8_SB(1, 0), b3, voffB);
            PG8_BAR; PG8_WAIT_L(0); PG8_MMA(0, 1, At, B1); PG8_BAR;
            PG8_LDA(At, 1, 1); PG8_STAGE(PG8_SA(1, 0), a3, voffA);
            PG8_BAR; PG8_WAIT_L(0); PG8_MMA(1, 0, At, B0); PG8_BAR; PG8_SCHED;
            PG8_STAGE(PG8_SB(1, 1), b3 + hstep, voffB);
            PG8_WAIT_V(6); PG8_BAR; PG8_MMA(1, 1, At, B1); PG8_BAR;
            }
        }
        if constexpr (ALIGN_EPI) { if (wr == 0) PG8_BAR; }
        if constexpr (!Epi::AFTER_DRAIN) { E(acc, cur, wr, wc, fr, fq); S.done(cur); }
        if (!has_next) break;
#pragma unroll
        for (int a = 0; a < 2; ++a)
#pragma unroll
            for (int b = 0; b < 2; ++b)
#pragma unroll
                for (int m = 0; m < 4; ++m)
#pragma unroll
                    for (int n = 0; n < 2; ++n) acc[a][b][m][n] = (f32x4){0.f, 0.f, 0.f, 0.f};
        cur = nxt; cA = nA; cB = nB; ++ui;
        if constexpr (ALIGN_EPI) { if (wr == 1) PG8_BAR; }
    }
    PG8_WAIT_V(0);
    if constexpr (!ALIGN_EPI) { if (wr == 0) PG8_BAR; }
    PG8_BAR;
    if constexpr (Epi::AFTER_DRAIN) { E.fused(acc, cur, wr, wc, fr, fq, lds, wid, lane); S.done(cur); }
#undef PG8_SA
#undef PG8_SB
#undef PG8_STAGE
#undef PG8_LDA
#undef PG8_LDB
#undef PG8_MMA
#undef PG8_WAIT_V
#undef PG8_WAIT_L
#undef PG8_BAR
#undef PG8_SCHED
}
}
#define GAS __attribute__((address_space(1)))
#define LAS __attribute__((address_space(3)))
typedef unsigned short bf16;
typedef unsigned v4u __attribute__((ext_vector_type(4)));
typedef float f32x4 __attribute__((ext_vector_type(4)));
typedef short bf16x8 __attribute__((ext_vector_type(8)));
typedef GAS unsigned gu32;
typedef GAS unsigned long long gu64;
#define RLX_AGENT __ATOMIC_RELAXED, __HIP_MEMORY_SCOPE_AGENT
#define LDS_WAIT() asm volatile("s_waitcnt lgkmcnt(0)" ::: "memory")
#define VM_WAIT() asm volatile("s_waitcnt vmcnt(0)" ::: "memory")
__device__ __forceinline__ unsigned long long rt() { return __builtin_amdgcn_s_memrealtime(); }
__device__ __forceinline__ unsigned f2bf(float f) { unsigned u = __builtin_bit_cast(unsigned, f); return (u + 0x7fffu + ((u >> 16) & 1u)) >> 16; }
__device__ __forceinline__ unsigned pk2(float lo, float hi) { return f2bf(lo) | (f2bf(hi) << 16); }

#define XB_TMO      128
#define XB_XCNT(j)  (256  + 64 * (j))
#define XB_XSUB(j)  (1280 + 64 * (j))
#define XB_XGEN(j)  (2304 + 64 * (j))
#define XB_TOP      3328
#define XB_TOPGEN   3392
#define XCD_BAR_WORDS 3456
#define XB_SPIN_CAP (1u << 18)

__device__ __forceinline__ unsigned xb_ld(unsigned* p)              { return __hip_atomic_load(p, __ATOMIC_RELAXED, __HIP_MEMORY_SCOPE_AGENT); }
__device__ __forceinline__ unsigned xb_add(unsigned* p, unsigned v) { return __hip_atomic_fetch_add(p, v, __ATOMIC_RELAXED, __HIP_MEMORY_SCOPE_AGENT); }
__device__ __forceinline__ unsigned xb_xcc_id() { return (unsigned)__builtin_amdgcn_s_getreg((3 << 11) | 20) & 0xFu; }
#define XB_SPIN(cond, bar) do { unsigned _sp = 0; while (cond) { __builtin_amdgcn_s_sleep(1); \
    if ((++_sp & 255u) == 0u) { if (xb_ld(&(bar)[XB_TMO])) break; if (_sp > XB_SPIN_CAP) { atomicAdd(&(bar)[XB_TMO], 1u); break; } } } } while (0)

struct XcdBarrier {
    unsigned* bar; unsigned x;
    volatile LAS unsigned* st;
};

__device__ __forceinline__ XcdBarrier xcd_barrier_post(unsigned* bar, volatile LAS unsigned* st) {
    XcdBarrier b; b.bar = bar; b.x = xb_xcc_id(); b.st = st;
    if (threadIdx.x == 0) (void)xb_add(&bar[XB_XCNT(b.x)], 1u);
    return b;
}
__device__ __forceinline__ void xcd_barrier_complete(unsigned* bar, unsigned x, unsigned& nloc, unsigned& nx) {
    const unsigned G = gridDim.x * gridDim.y * gridDim.z;
    unsigned sum, cnt, mine, sp = 0u;
    for (;;) {
        sum = 0u; cnt = 0u; mine = 0u;
#pragma unroll
        for (unsigned j = 0; j < 16; ++j) { const unsigned c = xb_ld(&bar[XB_XCNT(j)]); sum += c; cnt += (c > 0u) ? 1u : 0u; mine = (j == x) ? c : mine; }
        if (sum == G) break;
        __builtin_amdgcn_s_sleep(1);
        if ((++sp & 255u) == 0u) { if (xb_ld(&bar[XB_TMO])) break; if (sp > XB_SPIN_CAP) { atomicAdd(&bar[XB_TMO], 1u); break; } }
    }
    nloc = mine > 0u ? mine : 1u; nx = cnt > 0u ? cnt : 1u;
}

__device__ __forceinline__ void xcd_barrier(const XcdBarrier& b) {
    asm volatile("s_waitcnt vmcnt(0)" ::: "memory");
    __syncthreads();
    if (threadIdx.x == 0) {
        unsigned* bar = b.bar;
        __builtin_amdgcn_s_waitcnt(0);
        unsigned nloc = b.st[0], nx = b.st[1];
        if (nloc == 0u) { xcd_barrier_complete(bar, b.x, nloc, nx); b.st[0] = nloc; b.st[1] = nx; }
        const unsigned old = xb_add(&bar[XB_XSUB(b.x)], 1u);
        const unsigned gen = old / nloc;
        if (old + 1u == (gen + 1u) * nloc) {
            __builtin_amdgcn_fence(__ATOMIC_RELEASE, "agent");
            asm volatile("s_waitcnt vmcnt(0)" ::: "memory");
            const unsigned og = xb_add(&bar[XB_TOP], 1u);
            const unsigned tg = og / nx;
            if (og + 1u == (tg + 1u) * nx) xb_add(&bar[XB_TOPGEN], 1u);
            else XB_SPIN(xb_ld(&bar[XB_TOPGEN]) == tg, bar);
            __builtin_amdgcn_fence(__ATOMIC_ACQUIRE, "agent");
            xb_add(&bar[XB_XGEN(b.x)], 1u);
            asm volatile("s_waitcnt vmcnt(0)" ::: "memory");
        } else {
            XB_SPIN(xb_ld(&bar[XB_XGEN(b.x)]) == gen, bar);
            __builtin_amdgcn_fence(__ATOMIC_ACQUIRE, "agent");
            asm volatile("s_waitcnt vmcnt(0)" ::: "memory");
        }
    }
    __syncthreads();
}
__device__ __forceinline__ float wave_sum(float v) {
#pragma unroll
    for (int o = 1; o < 64; o <<= 1) v += __shfl_xor(v, o);
    return v;
}
__device__ __forceinline__ void p0_transpose_item(const float* W, int K, int N, bf16* WT, int row_off, LAS float* scr, int item, int lane, int ldw = 0) {
    if (ldw == 0) ldw = K;
    const int nblk = N / 32, kb = item / nblk, nb = item % nblk, k0 = 64 * kb, n0 = 32 * nb;
#pragma unroll 8
    for (int i = 0; i < 32; ++i) { const int kk = 2 * i + (lane >> 5); scr[kk * 33 + (lane & 31)] = W[(size_t)(k0 + kk) * N + n0 + (lane & 31)]; }
    LDS_WAIT(); asm volatile("" ::: "memory");
    const int c = lane & 7;
#pragma unroll
    for (int j = 0; j < 4; ++j) { const int n = (lane >> 3) + 8 * j; const LAS float* s = scr + (8 * c) * 33 + n;
        v4u o; o.x = pk2(s[0 * 33], s[1 * 33]); o.y = pk2(s[2 * 33], s[3 * 33]); o.z = pk2(s[4 * 33], s[5 * 33]); o.w = pk2(s[6 * 33], s[7 * 33]);
        *(GAS v4u*)(WT + (size_t)(row_off + n0 + n) * ldw + k0 + 8 * c) = o; }
    LDS_WAIT(); asm volatile("" ::: "memory");
}

constexpr int NWAVES = 8;
#ifndef MK_N_LAUNCHES
#define MK_N_LAUNCHES 1
#endif
constexpr int NPH = 13;
constexpr int N_LAUNCHES = MK_N_LAUNCHES;
static_assert(N_LAUNCHES == 1 || N_LAUNCHES == NPH, "MK_N_LAUNCHES is 1 or NPH");

constexpr int TOK = 8192, DM = 2048, SEQ = 4096, NIN = 9216, MEMT = 512;
constexpr float EPS = 1e-6f;
constexpr size_t MiB = 1u << 20;
constexpr size_t WS_CTL = 0, CTL_ZERO_BYTES = 1 * MiB;
constexpr size_t WS_SUBK = 1 * MiB;
constexpr size_t WS_PS1 = 2 * MiB, WS_PS2 = 3 * MiB;
constexpr size_t WS_WIN = 4 * MiB;
constexpr size_t WS_WUPA = 40 * MiB, WS_WUPB = 44 * MiB;
constexpr size_t WS_WOUT = 48 * MiB, WS_WMQ = 56 * MiB, WS_WMKV = 64 * MiB, WS_WMO = 80 * MiB, WS_WPQ = 88 * MiB;
constexpr size_t WS_PU = 96 * MiB, WS_PV = 160 * MiB;
constexpr size_t WS_S0 = 224 * MiB;
constexpr size_t WS_S1 = 256 * MiB;
constexpr size_t WS_S2 = 288 * MiB;
constexpr size_t WS_S3 = 320 * MiB;
constexpr size_t WS_S4 = 352 * MiB;
constexpr size_t WS_S6 = 416 * MiB;
constexpr size_t WS_KM = 480 * MiB, WS_VTM = 482 * MiB, WS_MN = 484 * MiB, WS_END = 486 * MiB;
constexpr int CW_TMO = 0, CW_CODE = 1, CW_BAR = 4096;

constexpr int RING_OFF = 0, RING_BYTES = 131072;
constexpr int LDSCTL_OFF = RING_BYTES, MISC_OFF = LDSCTL_OFF + 320;
constexpr int LDS_BYTES = 147456;

typedef float f32x2g __attribute__((ext_vector_type(2)));
typedef unsigned u32x2 __attribute__((ext_vector_type(2)));
#define DI __device__ __forceinline__
#define MFMA16(a, b, c) __builtin_amdgcn_mfma_f32_16x16x32_bf16((a), (b), (c), 0, 0, 0)

struct Frame {
    LAS unsigned char* lds;
    volatile LAS unsigned* MISC;
    gu32* ctl;
    int tid, lane, wave, vcu, G;
    const float* in[23];
    float* out; unsigned char* ws;
};
enum { I_X = 0, I_MEM, I_GMIX, I_WIN, I_LNG, I_LNB, I_WS, I_BS, I_RELB, I_WUPA, I_WUPB, I_WOUT, I_GMQ, I_GMKV, I_MWQ, I_MWKV, I_MWO, I_GFFN, I_PWQ, I_SUBK, I_PU, I_PV, I_GFIN };

DI float wave_max(float v) {
#pragma unroll
    for (int o = 1; o < 64; o <<= 1) v = fmaxf(v, __shfl_xor(v, o));
    return v;
}
DI float gelu1(float v) {
    const float av = fabsf(v), t = __builtin_amdgcn_rcpf(av * 0.2316418882f + 1.0f);
    float q = t * 0.5307027145f + (-0.7265760135f); q = q * t + 0.7107068705f; q = q * t + (-0.142248368f); q = q * t + 0.127414796f; q = q * t;
    const float e = __builtin_amdgcn_exp2f((v * v) * (-0.72134752044f)); const float m = v * (q * e);
    return v < 0.f ? m : v - m;
}
DI float bflo(unsigned w) { return __builtin_bit_cast(float, w << 16); }
DI float bfhi(unsigned w) { return __builtin_bit_cast(float, w & 0xffff0000u); }

DI void rms_row_to_bf16(int lane, const float* xrow, const float* gain, bf16* orow) {
    const GAS f32x4* xr = (const GAS f32x4*)xrow + lane; const GAS f32x4* gr = (const GAS f32x4*)gain + lane;
    f32x4 v[8]; float s = 0.f;
#pragma unroll
    for (int j = 0; j < 8; ++j) { v[j] = xr[64 * j]; s += (v[j].x * v[j].x + v[j].y * v[j].y) + (v[j].z * v[j].z + v[j].w * v[j].w); }
    const float rstd = 1.0f / sqrtf(wave_sum(s) * (1.f / DM) + EPS);
    GAS unsigned long long* o8 = (GAS unsigned long long*)orow + lane;
#pragma unroll
    for (int j = 0; j < 8; ++j) { const f32x4 g = gr[64 * j];
        o8[64 * j] = (unsigned long long)pk2(v[j].x * rstd * g.x, v[j].y * rstd * g.y) | ((unsigned long long)pk2(v[j].z * rstd * g.z, v[j].w * rstd * g.w) << 32); }
}
DI void p0_prologue(Frame& F) {
    LAS float* scr = (LAS float*)(F.lds + RING_OFF + F.wave * 16384);
    const int gw = F.vcu * NWAVES + F.wave, NGW = F.G * NWAVES;
    unsigned char* ws = F.ws;
    constexpr int I_IN = (DM / 64) * (NIN / 32), I_UP = (1024 / 64) * (DM / 32), I_SQ = (DM / 64) * (DM / 32), I_KV = (DM / 64) * (4096 / 32);
    constexpr int NITEMS = I_IN + 2 * I_UP + 4 * I_SQ + I_KV;
    for (int it = gw; it < NITEMS; it += NGW) {
        int r = it;
        if (r < I_IN) { p0_transpose_item(F.in[I_WIN], DM, NIN, (bf16*)(ws + WS_WIN), 0, scr, r, F.lane); continue; } r -= I_IN;
        if (r < I_UP) { p0_transpose_item(F.in[I_WUPA], 1024, DM, (bf16*)(ws + WS_WUPA), 0, scr, r, F.lane); continue; } r -= I_UP;
        if (r < I_UP) { p0_transpose_item(F.in[I_WUPB], 1024, DM, (bf16*)(ws + WS_WUPB), 0, scr, r, F.lane); continue; } r -= I_UP;
        if (r < I_SQ) { p0_transpose_item(F.in[I_WOUT], DM, DM, (bf16*)(ws + WS_WOUT), 0, scr, r, F.lane); continue; } r -= I_SQ;
        if (r < I_SQ) { p0_transpose_item(F.in[I_MWQ], DM, DM, (bf16*)(ws + WS_WMQ), 0, scr, r, F.lane); continue; } r -= I_SQ;
        if (r < I_SQ) { p0_transpose_item(F.in[I_MWO], DM, DM, (bf16*)(ws + WS_WMO), 0, scr, r, F.lane); continue; } r -= I_SQ;
        if (r < I_SQ) { p0_transpose_item(F.in[I_PWQ], DM, DM, (bf16*)(ws + WS_WPQ), 0, scr, r, F.lane); continue; } r -= I_SQ;
        p0_transpose_item(F.in[I_MWKV], DM, 4096, (bf16*)(ws + WS_WMKV), 0, scr, r, F.lane);
    }
    {
        const size_t gt = (size_t)(F.vcu * NWAVES + F.wave) * 64 + F.lane, NT = (size_t)F.G * NWAVES * 64;
        constexpr size_t NG = (size_t)16384 * 2048 / 8;
        for (size_t i = gt; i < 2 * NG; i += NT) {
            const bool second = i >= NG; const size_t g = second ? i - NG : i;
            const GAS f32x4* s = (const GAS f32x4*)(second ? F.in[I_PV] : F.in[I_PU]) + 2 * g;
            const f32x4 a = s[0], b = s[1];
            v4u o; o.x = pk2(a.x, a.y); o.y = pk2(a.z, a.w); o.z = pk2(b.x, b.y); o.w = pk2(b.z, b.w);
            *((GAS v4u*)(ws + (second ? WS_PV : WS_PU)) + g) = o;
        }
        for (size_t i = gt; i < 2 * 128 * 128 / 8; i += NT) {
            const GAS f32x4* s = (const GAS f32x4*)F.in[I_SUBK] + 2 * i; const f32x4 a = s[0], b = s[1];
            v4u o; o.x = pk2(a.x, a.y); o.y = pk2(a.z, a.w); o.z = pk2(b.x, b.y); o.w = pk2(b.z, b.w);
            *((GAS v4u*)(ws + WS_SUBK) + i) = o;
        }
    }
    for (int m = gw; m < TOK; m += NGW) rms_row_to_bf16(F.lane, F.in[I_X] + (size_t)m * DM, F.in[I_GMIX], (bf16*)(ws + WS_S0) + (size_t)m * DM);
    for (int m = gw; m < MEMT; m += NGW) rms_row_to_bf16(F.lane, F.in[I_MEM] + (size_t)m * DM, F.in[I_GMKV], (bf16*)(ws + WS_MN) + (size_t)m * DM);
}

DI void sg_unit(Frame& F, int unit) {
    const int blk = unit >> 2, g = unit & 3, tid = F.tid, lane = F.lane, w = F.wave, fr = lane & 15, fq = lane >> 4;
    LAS float* RED = (LAS float*)(F.lds);
    LAS float* ST = (LAS float*)(F.lds + 8192);
    LAS float* R01 = (LAS float*)(F.lds + 9216);
    LAS bf16* WP = (LAS bf16*)(F.lds + 10240);
    const bf16* ZVT = (const bf16*)(F.ws + WS_S1 + 16 * MiB) + (size_t)blk * 1024 * 128;
    __syncthreads();
    {
        const GAS unsigned* p = (const GAS unsigned*)(ZVT + (size_t)(w * 128) * 128) + lane;
        float s0 = 0.f, s1 = 0.f, q0 = 0.f, q1 = 0.f;
#pragma unroll 16
        for (int c = 0; c < 128; ++c) { const unsigned v = p[c * 64]; const float a = bflo(v), b = bfhi(v); s0 += a; q0 += a * a; s1 += b; q1 += b * b; }
        RED[(w * 128 + 2 * lane) * 2] = s0; RED[(w * 128 + 2 * lane) * 2 + 1] = q0; RED[(w * 128 + 2 * lane + 1) * 2] = s1; RED[(w * 128 + 2 * lane + 1) * 2 + 1] = q1;
    }
    __syncthreads();
    if (tid < 128) { float s = 0.f, q = 0.f;
#pragma unroll
        for (int k = 0; k < 8; ++k) { s += RED[(k * 128 + tid) * 2]; q += RED[(k * 128 + tid) * 2 + 1]; }
        const float mean = s * (1.f / 1024.f); float var = q * (1.f / 1024.f) - mean * mean; var = var < 0.f ? 0.f : var;
        ST[tid * 2] = mean; ST[tid * 2 + 1] = 1.0f / sqrtf(var + EPS); }
    __syncthreads();
    {
        const float* Wg = F.in[I_WS] + (size_t)g * 128 * 128;
#pragma unroll
        for (int k = 0; k < 4; ++k) { const int id = tid + 512 * k, i = id >> 4, j0 = (id & 15) * 8;
            const f32x4 a = *(const GAS f32x4*)(Wg + i * 128 + j0), b = *(const GAS f32x4*)(Wg + i * 128 + j0 + 4);
            const float mk = ((i >> 6) >= (j0 >> 6)) ? 1.f : 0.f;
            float v[8] = {a.x, a.y, a.z, a.w, b.x, b.y, b.z, b.w}; unsigned o[4];
#pragma unroll
            for (int e = 0; e < 4; ++e) o[e] = pk2(v[2 * e] * mk * ST[(j0 + 2 * e) * 2 + 1], v[2 * e + 1] * mk * ST[(j0 + 2 * e + 1) * 2 + 1]);
            *(LAS v4u*)(WP + i * 136 + j0) = (v4u){o[0], o[1], o[2], o[3]}; }
    }
    __syncthreads();
    if (tid < 128) { const float* Wr = F.in[I_WS] + (size_t)g * 128 * 128 + tid * 128; float r0 = 0.f, r1 = 0.f; const int jmax = (tid >> 6) ? 128 : 64;
        for (int j = 0; j < jmax; ++j) { r0 += Wr[j]; r1 += bflo((unsigned)WP[tid * 136 + j]) * ST[j * 2]; }
        R01[tid * 2] = r0; R01[tid * 2 + 1] = r1; }
    __syncthreads();
    const int wr = w >> 2, wc = w & 3;
    f32x4 acc[4][4];
#pragma unroll
    for (int m = 0; m < 4; ++m)
#pragma unroll
        for (int n = 0; n < 4; ++n) acc[m][n] = (f32x4){0.f, 0.f, 0.f, 0.f};
    const bf16* Bg = ZVT + (size_t)(g * 256 + wc * 64 + fr) * 128 + 8 * fq;
#pragma unroll
    for (int ks = 0; ks < 4; ++ks) {
        bf16x8 bfrag[4], afrag[4];
#pragma unroll
        for (int n = 0; n < 4; ++n) bfrag[n] = *(const GAS bf16x8*)(Bg + (size_t)(16 * n) * 128 + ks * 32);
#pragma unroll
        for (int m = 0; m < 4; ++m) afrag[m] = *(const LAS bf16x8*)(WP + (wr * 64 + 16 * m + fr) * 136 + ks * 32 + 8 * fq);
#pragma unroll
        for (int m = 0; m < 4; ++m)
#pragma unroll
            for (int n = 0; n < 4; ++n) acc[m][n] = MFMA16(bfrag[n], afrag[m], acc[m][n]);
    }
    const bf16* ZU = (const bf16*)(F.ws + WS_S1); bf16* YA = (bf16*)(F.ws + WS_S3);
#pragma unroll
    for (int m = 0; m < 4; ++m) { const int i = wr * 64 + 16 * m + fr; const float r0 = R01[i * 2], r1 = R01[i * 2 + 1], bs = F.in[I_BS][g * 128 + i]; const size_t trow = (size_t)(blk * 128 + i) * 1024;
#pragma unroll
        for (int n = 0; n < 4; ++n) { const int ch = g * 256 + wc * 64 + 16 * n + 4 * fq;
            const f32x4 lg = *(const GAS f32x4*)(F.in[I_LNG] + ch), lb = *(const GAS f32x4*)(F.in[I_LNB] + ch);
            const u32x2 zu = *(const GAS u32x2*)(ZU + trow + ch);
            const float s0 = lg.x * (acc[m][n][0] - r1) + lb.x * r0 + bs, s1 = lg.y * (acc[m][n][1] - r1) + lb.y * r0 + bs, s2 = lg.z * (acc[m][n][2] - r1) + lb.z * r0 + bs, s3 = lg.w * (acc[m][n][3] - r1) + lb.w * r0 + bs;
            u32x2 o; o.x = pk2(bflo(zu.x) * s0, bfhi(zu.x) * s1); o.y = pk2(bflo(zu.y) * s2, bfhi(zu.y) * s3);
            *(GAS u32x2*)(YA + trow + ch) = o; } }
}

DI void attn_unit(Frame& F, int unit) {
    const int cp = unit & 31, h = (unit >> 5) & 7, b = unit >> 8, tid = F.tid, lane = F.lane, w = F.wave, fr = lane & 15, fq = lane >> 4;
    LAS bf16* QL = (LAS bf16*)(F.lds);
    LAS bf16* KL = QL + 128 * 136;
    LAS bf16* VL = KL + 64 * 136;
    LAS bf16* PL = VL + 128 * 72;
    LAS float* BL = (LAS float*)(PL + 8 * 16 * 72);
    const bf16* QK = (const bf16*)(F.ws + WS_S2); const bf16* VT = (const bf16*)(F.ws + WS_S6); bf16* YB = (bf16*)(F.ws + WS_S3 + 16 * MiB);
    const int t0 = cp * 128, cq = 2 * cp + (w >> 2);
    const int kt_lo = (2 * cp - 8) < 0 ? 0 : (2 * cp - 8), kt_hi = 2 * cp + 1;
    __syncthreads();
    for (int i = tid; i < 257; i += 512) BL[i] = F.in[I_RELB][h * 257 + i];
#pragma unroll
    for (int k = 0; k < 4; ++k) { const int id = tid + 512 * k, r = id >> 4, ch = id & 15;
        *(LAS v4u*)(QL + r * 136 + ch * 8) = *(const GAS v4u*)(QK + (size_t)(b * SEQ + t0 + r) * 2048 + h * 128 + ch * 8); }
    v4u kreg[2], vreg[2];
#define ATT_PREFETCH(kt) do { _Pragma("unroll") for (int k = 0; k < 2; ++k) { const int id = tid + 512 * k; \
        kreg[k] = *(const GAS v4u*)(QK + (size_t)(b * SEQ + (kt) * 64 + (id >> 4)) * 2048 + 1024 + h * 128 + (id & 15) * 8); \
        vreg[k] = *(const GAS v4u*)(VT + (size_t)((b * 8 + h) * 128 + (id >> 3)) * 4096 + (kt) * 64 + (id & 7) * 8); } } while (0)
    ATT_PREFETCH(kt_lo);
    f32x4 o[8]; float m_run = -1e30f, l_run = 0.f;
#pragma unroll
    for (int n = 0; n < 8; ++n) o[n] = (f32x4){0.f, 0.f, 0.f, 0.f};
    bf16x8 qf[4];
    for (int kt = kt_lo; kt <= kt_hi; ++kt) {
        __syncthreads();
#pragma unroll
        for (int k = 0; k < 2; ++k) { const int id = tid + 512 * k; *(LAS v4u*)(KL + (id >> 4) * 136 + (id & 15) * 8) = kreg[k]; *(LAS v4u*)(VL + (id >> 3) * 72 + (id & 7) * 8) = vreg[k]; }
        __syncthreads();
        if (kt == kt_lo) {
#pragma unroll
            for (int ks = 0; ks < 4; ++ks) qf[ks] = *(const LAS bf16x8*)(QL + (16 * w + fr) * 136 + ks * 32 + 8 * fq);
        }
        if (kt < kt_hi) ATT_PREFETCH(kt + 1);
        if (kt >= cq - 8 && kt <= cq) {
            f32x4 s[4];
#pragma unroll
            for (int n = 0; n < 4; ++n) s[n] = (f32x4){0.f, 0.f, 0.f, 0.f};
#pragma unroll
            for (int ks = 0; ks < 4; ++ks)
#pragma unroll
                for (int n = 0; n < 4; ++n) { const bf16x8 kf = *(const LAS bf16x8*)(KL + (16 * n + fr) * 136 + ks * 32 + 8 * fq); s[n] = MFMA16(kf, qf[ks], s[n]); }
            const int dbase = (t0 + 16 * w + fr) - kt * 64 - 4 * fq;
            float mx = -1e30f;
#pragma unroll
            for (int n = 0; n < 4; ++n)
#pragma unroll
                for (int e = 0; e < 4; ++e) { int d = dbase - 16 * n - e; d = d < -128 ? -128 : (d > 128 ? 128 : d); const float v = s[n][e] + BL[d + 128]; s[n][e] = v; mx = fmaxf(mx, v); }
            mx = fmaxf(mx, __shfl_xor(mx, 16)); mx = fmaxf(mx, __shfl_xor(mx, 32));
            const float m_new = fmaxf(m_run, mx), alpha = __expf(m_run - m_new); float rs = 0.f;
#pragma unroll
            for (int n = 0; n < 4; ++n) { const float p0 = __expf(s[n][0] - m_new), p1 = __expf(s[n][1] - m_new), p2 = __expf(s[n][2] - m_new), p3 = __expf(s[n][3] - m_new);
                rs += (p0 + p1) + (p2 + p3); u32x2 pw; pw.x = pk2(p0, p1); pw.y = pk2(p2, p3);
                *(LAS u32x2*)(PL + (w * 16 + fr) * 72 + 16 * n + 4 * fq) = pw; }
            rs += __shfl_xor(rs, 16); rs += __shfl_xor(rs, 32);
            l_run = l_run * alpha + rs; m_run = m_new;
#pragma unroll
            for (int n = 0; n < 8; ++n) o[n] = o[n] * alpha;
            LDS_WAIT();
#pragma unroll
            for (int ks = 0; ks < 2; ++ks) { const bf16x8 pf = *(const LAS bf16x8*)(PL + (w * 16 + fr) * 72 + ks * 32 + 8 * fq);
#pragma unroll
                for (int n = 0; n < 8; ++n) { const bf16x8 vf = *(const LAS bf16x8*)(VL + (16 * n + fr) * 72 + ks * 32 + 8 * fq); o[n] = MFMA16(vf, pf, o[n]); } }
        }
    }
#undef ATT_PREFETCH
    const float inv = 1.0f / l_run; bf16* orow = YB + (size_t)(b * SEQ + t0 + 16 * w + fr) * 1024 + h * 128 + 4 * fq;
#pragma unroll
    for (int n = 0; n < 8; ++n) { u32x2 ow; ow.x = pk2(o[n][0] * inv, o[n][1] * inv); ow.y = pk2(o[n][2] * inv, o[n][3] * inv); *(GAS u32x2*)(orow + 16 * n) = ow; }
}

DI void xattn_unit(Frame& F, int unit) {
    const int rt = unit & 63, hm = (unit >> 6) & 3, b = unit >> 8, tid = F.tid, lane = F.lane, w = F.wave, fr = lane & 15, fq = lane >> 4, wr = w >> 1, wc = w & 1;
    LAS bf16* QC = (LAS bf16*)(F.lds);
    LAS bf16* KC = QC + 64 * 136;
    LAS bf16* SP = KC + 256 * 136;
    LAS float* RED = (LAS float*)(SP + 64 * 264);
    const bf16* QM = (const bf16*)(F.ws + WS_S1); const bf16* KM = (const bf16*)(F.ws + WS_KM); const bf16* VTM = (const bf16*)(F.ws + WS_VTM); bf16* OC = (bf16*)(F.ws + WS_S0);
    const size_t row0 = (size_t)b * SEQ + rt * 64;
    f32x4 s[8];
#pragma unroll
    for (int n = 0; n < 8; ++n) s[n] = (f32x4){0.f, 0.f, 0.f, 0.f};
    for (int dc = 0; dc < 4; ++dc) {
        __syncthreads();
#pragma unroll
        for (int k = 0; k < 2; ++k) { const int id = tid + 512 * k, r = id >> 4, ch = id & 15;
            *(LAS v4u*)(QC + r * 136 + ch * 8) = *(const GAS v4u*)(QM + (row0 + r) * 2048 + hm * 512 + dc * 128 + ch * 8); }
#pragma unroll
        for (int k = 0; k < 8; ++k) { const int id = tid + 512 * k, r = id >> 4, ch = id & 15;
            *(LAS v4u*)(KC + r * 136 + ch * 8) = *(const GAS v4u*)(KM + (size_t)(b * 256 + r) * 2048 + hm * 512 + dc * 128 + ch * 8); }
        __syncthreads();
#pragma unroll
        for (int ks = 0; ks < 4; ++ks) { const bf16x8 af = *(const LAS bf16x8*)(QC + (16 * wr + fr) * 136 + ks * 32 + 8 * fq);
#pragma unroll
            for (int n = 0; n < 8; ++n) { const bf16x8 kf = *(const LAS bf16x8*)(KC + (128 * wc + 16 * n + fr) * 136 + ks * 32 + 8 * fq); s[n] = MFMA16(kf, af, s[n]); } }
    }
    float mx = -1e30f;
#pragma unroll
    for (int n = 0; n < 8; ++n) mx = fmaxf(mx, fmaxf(fmaxf(s[n][0], s[n][1]), fmaxf(s[n][2], s[n][3])));
    mx = fmaxf(mx, __shfl_xor(mx, 16)); mx = fmaxf(mx, __shfl_xor(mx, 32));
    if (fq == 0) RED[(16 * wr + fr) * 2 + wc] = mx;
    __syncthreads();
    mx = fmaxf(RED[(16 * wr + fr) * 2], RED[(16 * wr + fr) * 2 + 1]);
    float rs = 0.f;
#pragma unroll
    for (int n = 0; n < 8; ++n) { s[n][0] = __expf(s[n][0] - mx); s[n][1] = __expf(s[n][1] - mx); s[n][2] = __expf(s[n][2] - mx); s[n][3] = __expf(s[n][3] - mx); rs += (s[n][0] + s[n][1]) + (s[n][2] + s[n][3]); }
    rs += __shfl_xor(rs, 16); rs += __shfl_xor(rs, 32);
    __syncthreads();
    if (fq == 0) RED[(16 * wr + fr) * 2 + wc] = rs;
    __syncthreads();
    const float inv = 1.0f / (RED[(16 * wr + fr) * 2] + RED[(16 * wr + fr) * 2 + 1]);
#pragma unroll
    for (int n = 0; n < 8; ++n) { u32x2 pw; pw.x = pk2(s[n][0] * inv, s[n][1] * inv); pw.y = pk2(s[n][2] * inv, s[n][3] * inv);
        *(LAS u32x2*)(SP + (16 * wr + fr) * 264 + 128 * wc + 16 * n + 4 * fq) = pw; }
    LAS bf16* VC = KC;
    for (int dc = 0; dc < 4; ++dc) {
        __syncthreads();
#pragma unroll
        for (int k = 0; k < 8; ++k) { const int id = tid + 512 * k, d = id >> 5, ch = id & 31;
            *(LAS v4u*)(VC + d * 264 + ch * 8) = *(const GAS v4u*)(VTM + (size_t)((b * 4 + hm) * 512 + dc * 128 + d) * 256 + ch * 8); }
        __syncthreads();
        f32x4 o[4];
#pragma unroll
        for (int n = 0; n < 4; ++n) o[n] = (f32x4){0.f, 0.f, 0.f, 0.f};
#pragma unroll
        for (int ks = 0; ks < 8; ++ks) { const bf16x8 pf = *(const LAS bf16x8*)(SP + (16 * wr + fr) * 264 + ks * 32 + 8 * fq);
#pragma unroll
            for (int n = 0; n < 4; ++n) { const bf16x8 vf = *(const LAS bf16x8*)(VC + (64 * wc + 16 * n + fr) * 264 + ks * 32 + 8 * fq); o[n] = MFMA16(vf, pf, o[n]); } }
        bf16* orow = OC + (row0 + 16 * wr + fr) * 2048 + hm * 512 + dc * 128 + 64 * wc + 4 * fq;
#pragma unroll
        for (int n = 0; n < 4; ++n) { u32x2 ow; ow.x = pk2(o[n][0], o[n][1]); ow.y = pk2(o[n][2], o[n][3]); *(GAS u32x2*)(orow + 16 * n) = ow; }
    }
}

DI void score_unit(Frame& F, int unit) {
    const int p = unit & 1, h = (unit >> 1) & 7, tt = unit >> 4, lane = F.lane, w = F.wave, fr = lane & 15, fq = lane >> 4;
    const bf16* PQ = (const bf16*)(F.ws + WS_S0); const bf16* SK = (const bf16*)(F.ws + WS_SUBK) + (size_t)p * 128 * 128; float* SC = (float*)(F.ws + WS_S2);
    const int tok = tt * 128 + 16 * w + fr;
    f32x4 s[8];
#pragma unroll
    for (int n = 0; n < 8; ++n) s[n] = (f32x4){0.f, 0.f, 0.f, 0.f};
#pragma unroll
    for (int ks = 0; ks < 4; ++ks) { const bf16x8 af = *(const GAS bf16x8*)(PQ + (size_t)tok * 2048 + h * 256 + p * 128 + ks * 32 + 8 * fq);
#pragma unroll
        for (int n = 0; n < 8; ++n) { const bf16x8 kf = *(const GAS bf16x8*)(SK + (size_t)(16 * n + fr) * 128 + ks * 32 + 8 * fq); s[n] = MFMA16(kf, af, s[n]); } }
    float* so = SC + ((size_t)(tok * 8 + h) * 2 + p) * 128 + 4 * fq;
#pragma unroll
    for (int n = 0; n < 8; ++n) *(GAS f32x4*)(so + 16 * n) = s[n];
}

DI void top16_of_128(float x0, float x1, int lane, float& tv, int& ti) {
    tv = -3e38f; ti = 0;
    for (int r = 0; r < 16; ++r) {
        const float m = wave_max(fmaxf(x0, x1));
        const unsigned long long b0 = __ballot(x0 == m); int idx;
        if (b0) { const int l = __ffsll((long long)b0) - 1; idx = l; if (lane == l) x0 = -3e38f; }
        else { const unsigned long long b1 = __ballot(x1 == m); const int l = __ffsll((long long)b1) - 1; idx = 64 + l; if (lane == l) x1 = -3e38f; }
        if (lane == r) { tv = m; ti = idx; }
    }
}
DI void route_item(Frame& F, int q) {
    const int lane = F.lane;
    const float* sc = (const float*)(F.ws + WS_S2) + (size_t)q * 256;
    const float a0 = sc[lane], a1 = sc[64 + lane], b0 = sc[128 + lane], b1 = sc[192 + lane];
    float tv0, tv1; int ti0, ti1;
    top16_of_128(a0, a1, lane, tv0, ti0);
    top16_of_128(b0, b1, lane, tv1, ti1);
    float cv[4]; const float vj = __shfl(tv1, lane & 15);
#pragma unroll
    for (int k = 0; k < 4; ++k) cv[k] = __shfl(tv0, (lane >> 4) + 4 * k) + vj;
    float bv = -3e38f; int bc = 0;
    for (int r = 0; r < 16; ++r) {
        const float m = wave_max(fmaxf(fmaxf(cv[0], cv[1]), fmaxf(cv[2], cv[3])));
        int c = -1;
#pragma unroll
        for (int k = 0; k < 4; ++k) { if (c < 0) { const unsigned long long bb = __ballot(cv[k] == m); if (bb) { const int l = __ffsll((long long)bb) - 1; c = l + 64 * k; if (lane == l) cv[k] = -3e38f; } } }
        if (lane == r) { bv = m; bc = c; }
    }
    const int i1 = __shfl(ti0, bc >> 4), i2 = __shfl(ti1, bc & 15);
    const float top = __shfl(bv, 0);
    const float e = lane < 16 ? __expf(bv - top) : 0.f;
    const float sum = wave_sum(e);
    if (lane < 16) { ((int*)(F.ws + WS_S4))[(size_t)q * 16 + lane] = i1 * 128 + i2; ((float*)(F.ws + WS_S4 + 4 * MiB))[(size_t)q * 16 + lane] = e / sum; }
}

DI void peer_token(Frame& F, int t) {
    const int lane = F.lane;
    const float* Hrow = (const float*)(F.ws + WS_S6) + (size_t)t * DM;
    const bf16* PU = (const bf16*)(F.ws + WS_PU); const bf16* PV = (const bf16*)(F.ws + WS_PV);
    float xn[32]; float ss = 0.f;
#pragma unroll
    for (int j = 0; j < 4; ++j) { const f32x4 a = *(const GAS f32x4*)(Hrow + 8 * lane + 512 * j), b = *(const GAS f32x4*)(Hrow + 8 * lane + 512 * j + 4);
        xn[8 * j] = a.x; xn[8 * j + 1] = a.y; xn[8 * j + 2] = a.z; xn[8 * j + 3] = a.w; xn[8 * j + 4] = b.x; xn[8 * j + 5] = b.y; xn[8 * j + 6] = b.z; xn[8 * j + 7] = b.w;
        ss += (a.x * a.x + a.y * a.y) + (a.z * a.z + a.w * a.w) + (b.x * b.x + b.y * b.y) + (b.z * b.z + b.w * b.w); }
    const float rstd = 1.0f / sqrtf(wave_sum(ss) * (1.f / DM) + EPS);
#pragma unroll
    for (int j = 0; j < 4; ++j) { const f32x4 a = *(const GAS f32x4*)(F.in[I_GFFN] + 8 * lane + 512 * j), b = *(const GAS f32x4*)(F.in[I_GFFN] + 8 * lane + 512 * j + 4);
        xn[8 * j] *= rstd * a.x; xn[8 * j + 1] *= rstd * a.y; xn[8 * j + 2] *= rstd * a.z; xn[8 * j + 3] *= rstd * a.w; xn[8 * j + 4] *= rstd * b.x; xn[8 * j + 5] *= rstd * b.y; xn[8 * j + 6] *= rstd * b.z; xn[8 * j + 7] *= rstd * b.w; }
    const int* EI = (const int*)(F.ws + WS_S4) + (size_t)t * 128; const float* EG = (const float*)(F.ws + WS_S4 + 4 * MiB) + (size_t)t * 128;
    const int e_lo = EI[lane], e_hi = EI[64 + lane]; const float g_lo = EG[lane], g_hi = EG[64 + lane];
    float acc[32];
#pragma unroll
    for (int i = 0; i < 32; ++i) acc[i] = 0.f;
#ifndef DBG_SKIP_PEER
#define DBG_SKIP_PEER 0
#endif
    for (int k0 = 0; k0 < (DBG_SKIP_PEER ? 0 : 128); k0 += 4) {
        int ex[4]; float gt[4]; v4u ur[4][4];
#pragma unroll
        for (int q = 0; q < 4; ++q) { const int k = k0 + q; ex[q] = __builtin_amdgcn_readfirstlane(__shfl(k0 < 64 ? e_lo : e_hi, k & 63)); gt[q] = __shfl(k0 < 64 ? g_lo : g_hi, k & 63);
#pragma unroll
            for (int j = 0; j < 4; ++j) ur[q][j] = *(const GAS v4u*)(PU + (size_t)ex[q] * DM + 8 * lane + 512 * j); }
        float act[4];
#pragma unroll
        for (int q = 0; q < 4; ++q) { float d = 0.f;
#pragma unroll
            for (int j = 0; j < 4; ++j) { const v4u u = ur[q][j];
                d += (bflo(u.x) * xn[8 * j] + bfhi(u.x) * xn[8 * j + 1]) + (bflo(u.y) * xn[8 * j + 2] + bfhi(u.y) * xn[8 * j + 3]) + (bflo(u.z) * xn[8 * j + 4] + bfhi(u.z) * xn[8 * j + 5]) + (bflo(u.w) * xn[8 * j + 6] + bfhi(u.w) * xn[8 * j + 7]); }
            act[q] = gelu1(wave_sum(d)) * gt[q]; }
#pragma unroll
        for (int q = 0; q < 4; ++q) {
#pragma unroll
            for (int j = 0; j < 4; ++j) ur[q][j] = *(const GAS v4u*)(PV + (size_t)ex[q] * DM + 8 * lane + 512 * j); }
#pragma unroll
        for (int q = 0; q < 4; ++q)
#pragma unroll
            for (int j = 0; j < 4; ++j) { const v4u v = ur[q][j]; const float a = act[q];
                acc[8 * j] += a * bflo(v.x); acc[8 * j + 1] += a * bfhi(v.x); acc[8 * j + 2] += a * bflo(v.y); acc[8 * j + 3] += a * bfhi(v.y);
                acc[8 * j + 4] += a * bflo(v.z); acc[8 * j + 5] += a * bfhi(v.z); acc[8 * j + 6] += a * bflo(v.w); acc[8 * j + 7] += a * bfhi(v.w); }
    }
    float s3 = 0.f;
#pragma unroll
    for (int j = 0; j < 4; ++j) { const f32x4 a = *(const GAS f32x4*)(Hrow + 8 * lane + 512 * j), b = *(const GAS f32x4*)(Hrow + 8 * lane + 512 * j + 4);
        acc[8 * j] += a.x; acc[8 * j + 1] += a.y; acc[8 * j + 2] += a.z; acc[8 * j + 3] += a.w; acc[8 * j + 4] += b.x; acc[8 * j + 5] += b.y; acc[8 * j + 6] += b.z; acc[8 * j + 7] += b.w;
#pragma unroll
        for (int e = 0; e < 8; ++e) s3 += acc[8 * j + e] * acc[8 * j + e]; }
    const float r3 = 1.0f / sqrtf(wave_sum(s3) * (1.f / DM) + EPS);
    float* orow = F.out + (size_t)t * DM;
#pragma unroll
    for (int j = 0; j < 4; ++j) { const f32x4 a = *(const GAS f32x4*)(F.in[I_GFIN] + 8 * lane + 512 * j), b = *(const GAS f32x4*)(F.in[I_GFIN] + 8 * lane + 512 * j + 4);
        *(GAS f32x4*)(orow + 8 * lane + 512 * j) = (f32x4){acc[8 * j] * r3 * a.x, acc[8 * j + 1] * r3 * a.y, acc[8 * j + 2] * r3 * a.z, acc[8 * j + 3] * r3 * a.w};
        *(GAS f32x4*)(orow + 8 * lane + 512 * j + 4) = (f32x4){acc[8 * j + 4] * r3 * b.x, acc[8 * j + 5] * r3 * b.y, acc[8 * j + 6] * r3 * b.z, acc[8 * j + 7] * r3 * b.w}; }
}

struct Args { const float* in[23]; float* out; unsigned char* ws; int ph_lo, ph_hi, li, pad; };
__global__ void __launch_bounds__(NWAVES * 64, 2) mk_fwd(Args args) {
    extern __shared__ __attribute__((aligned(16))) unsigned char lds[];
    Frame F;
    F.lds = (LAS unsigned char*)lds;
    F.MISC = (volatile LAS unsigned*)(F.lds + MISC_OFF);
    F.tid = threadIdx.x; F.lane = F.tid & 63; F.wave = __builtin_amdgcn_readfirstlane(F.tid >> 6);
    F.G = gridDim.x; { const int bx = blockIdx.x; F.vcu = (F.G % 8 == 0) ? (bx % 8) * (F.G / 8) + bx / 8 : bx; }
#pragma unroll
    for (int i = 0; i < 23; ++i) F.in[i] = args.in[i];
    F.out = args.out; F.ws = args.ws; unsigned char* ws = args.ws;
    F.ctl = (gu32*)(ws + WS_CTL);
    for (int u = F.tid; u < (LDS_BYTES - LDSCTL_OFF) / 4; u += NWAVES * 64) ((LAS unsigned*)(F.lds + LDSCTL_OFF))[u] = 0u;
    __syncthreads();
    XcdBarrier bar; bar.bar = (unsigned*)(F.ctl + CW_BAR); bar.x = 0; bar.st = nullptr;
    if (N_LAUNCHES == 1) bar = xcd_barrier_post((unsigned*)(F.ctl + CW_BAR), F.MISC + 8);
#define GRID_BAR() do { if (N_LAUNCHES == 1) xcd_barrier(bar); } while (0)
    const int lo = args.ph_lo, hi = args.ph_hi;
#ifndef DBG_STOP
#define DBG_STOP 99
#endif
#define IN(k) (lo <= (k) && (k) < hi && ((k) <= DBG_STOP || (k) == NPH - 1))
#define BOTH(k) (IN(k) && hi > (k) + 1)
    const int bx = (int)blockIdx.x, G = F.G;

#if defined(DBG_GEMMTEST)
    {
        p0_prologue(F); GRID_BAR();
#define GT_ONE(rep) { pg8::Gemm g{(const pg8::bf16_t*)(ws + WS_S0), (const pg8::bf16_t*)(ws + GT_W), TOK, GT_N, DM}; pg8::StaticOrder S; S.init(TOK, GT_N, G, bx); \
          pg8::EpiPlain E{(pg8::bf16_t*)(ws + (256 + 64 * (rep)) * MiB), GT_N}; pg8::gemm_phase<pg8::EpiPlain, pg8::StaticOrder, GT_ALIGN, GT_SP2>(F.lds + RING_OFF, g, S, E); GRID_BAR(); }
        GT_ONE(0) GT_ONE(1) GT_ONE(2) GT_ONE(3)
        { const size_t nw = (size_t)TOK * GT_N / 2, gt = (size_t)(F.vcu * NWAVES + F.wave) * 64 + F.lane, NT = (size_t)G * NWAVES * 64; unsigned cnt = 0;
          const unsigned* o0 = (const unsigned*)(ws + 256 * MiB); const unsigned* o1 = (const unsigned*)(ws + 320 * MiB); const unsigned* o2 = (const unsigned*)(ws + 384 * MiB); const unsigned* o3 = (const unsigned*)(ws + 448 * MiB);
          for (size_t i = gt; i < nw; i += NT) { const unsigned a = o0[i]; cnt += (a != o1[i]) + (a != o2[i]) + (a != o3[i]); }
          if (cnt) atomicAdd((unsigned*)(F.ctl + 2048), cnt);
          GRID_BAR();
          const float r = (float)__hip_atomic_load((unsigned*)(F.ctl + 2048), __ATOMIC_RELAXED, __HIP_MEMORY_SCOPE_AGENT);
          for (size_t i = gt; i < (size_t)TOK * DM; i += NT) F.out[i] = r; }
        return;
    }
#endif
#if defined(DBG_P1TEST)
    {
        p0_prologue(F); GRID_BAR();
#define P1T_RUN(ZUo, QKo, GABo, VTo) { pg8::Gemm g{(const pg8::bf16_t*)(ws + WS_S0), (const pg8::bf16_t*)(ws + WS_WIN), TOK, NIN, DM}; pg8::StaticOrder S; S.init(TOK, NIN, G, bx); \
          pg8::EpiIn E{(pg8::bf16_t*)(ws + (ZUo)), (pg8::bf16_t*)(ws + (ZUo) + 16 * MiB), (pg8::bf16_t*)(ws + (QKo)), (pg8::bf16_t*)(ws + (VTo)), (pg8::bf16_t*)(ws + (GABo)), 0.08838834764831845f}; \
          pg8::gemm_phase<pg8::EpiIn, pg8::StaticOrder, P1T_ALIGN, P1T_SP2>(F.lds + RING_OFF, g, S, E); GRID_BAR(); }
        P1T_RUN(WS_S1, WS_S2, WS_S4, WS_S6)
        P1T_RUN(96 * MiB, 128 * MiB, 160 * MiB, 432 * MiB)
        { const size_t gt = (size_t)(F.vcu * NWAVES + F.wave) * 64 + F.lane, NT = (size_t)G * NWAVES * 64; unsigned cnt = 0;
#define P1T_CMP(a, b, mib) { const unsigned* pa = (const unsigned*)(ws + (a)); const unsigned* pb = (const unsigned*)(ws + (b)); for (size_t i = gt; i < (size_t)(mib) * MiB / 4; i += NT) cnt += (pa[i] != pb[i]); }
          P1T_CMP(WS_S1, 96 * MiB, 32) P1T_CMP(WS_S2, 128 * MiB, 32) P1T_CMP(WS_S4, 160 * MiB, 64) P1T_CMP(WS_S6, 432 * MiB, 16)
          if (cnt) atomicAdd((unsigned*)(F.ctl + 2048), cnt);
          GRID_BAR();
          const float r = (float)__hip_atomic_load((unsigned*)(F.ctl + 2048), __ATOMIC_RELAXED, __HIP_MEMORY_SCOPE_AGENT);
          for (size_t i = gt; i < (size_t)TOK * DM; i += NT) F.out[i] = r; }
        return;
    }
#endif
    if (IN(0)) { p0_prologue(F); if (BOTH(0)) GRID_BAR(); }

    if (IN(1)) {
        { pg8::Gemm g{(const pg8::bf16_t*)(ws + WS_S0), (const pg8::bf16_t*)(ws + WS_WIN), TOK, NIN, DM}; pg8::StaticOrder S; S.init(TOK, NIN, G, bx);
          pg8::EpiIn E{(pg8::bf16_t*)(ws + WS_S1), (pg8::bf16_t*)(ws + WS_S1 + 16 * MiB), (pg8::bf16_t*)(ws + WS_S2), (pg8::bf16_t*)(ws + WS_S6), (pg8::bf16_t*)(ws + WS_S4), 0.08838834764831845f};
          pg8::gemm_phase<pg8::EpiIn, pg8::StaticOrder, true, true>(F.lds + RING_OFF, g, S, E); }
        { pg8::Gemm g{(const pg8::bf16_t*)(ws + WS_MN), (const pg8::bf16_t*)(ws + WS_WMKV), MEMT, 4096, DM}; pg8::ShiftedOrder S; S.init(MEMT, 4096, G, bx, G >= 160 ? 128 : 0);
          pg8::EpiKV E{(pg8::bf16_t*)(ws + WS_KM), (pg8::bf16_t*)(ws + WS_VTM)};
          pg8::gemm_phase<pg8::EpiKV, pg8::ShiftedOrder, false, true>(F.lds + RING_OFF, g, S, E); }
        if (BOTH(1)) GRID_BAR();
    }

    if (IN(2)) {
        for (int u = F.vcu; u < 256; u += G) sg_unit(F, u);
        for (int u = F.vcu * 2; u < 512; u += 2 * G) { attn_unit(F, u); if (u + 1 < 512) attn_unit(F, u + 1); }
        if (BOTH(2)) GRID_BAR();
    }

    if (IN(3)) {
        pg8::Gemm g{(const pg8::bf16_t*)(ws + WS_S3), (const pg8::bf16_t*)(ws + WS_WUPA), TOK, DM, 1024}; pg8::StaticOrder S; S.init(TOK, DM, G, bx);
        pg8::EpiUp<true> E{(const pg8::bf16_t*)(ws + WS_S4), (pg8::bf16_t*)(ws + WS_S0), (pg8::bf16_t*)(ws + WS_S1)};
        pg8::gemm_phase<pg8::EpiUp<true>, pg8::StaticOrder, false, true>(F.lds + RING_OFF, g, S, E);
        if (BOTH(3)) GRID_BAR();
    }
    if (IN(4)) {
        pg8::Gemm g{(const pg8::bf16_t*)(ws + WS_S3 + 16 * MiB), (const pg8::bf16_t*)(ws + WS_WUPB), TOK, DM, 1024}; pg8::StaticOrder S; S.init(TOK, DM, G, bx);
        pg8::EpiUp<false> E{(const pg8::bf16_t*)(ws + WS_S4), (pg8::bf16_t*)(ws + WS_S0), (pg8::bf16_t*)(ws + WS_S1)};
        pg8::gemm_phase<pg8::EpiUp<false>, pg8::StaticOrder, false, true>(F.lds + RING_OFF, g, S, E);
        if (BOTH(4)) GRID_BAR();
    }

    if (IN(5)) {
        pg8::Gemm g{(const pg8::bf16_t*)(ws + WS_S1), (const pg8::bf16_t*)(ws + WS_WOUT), TOK, DM, DM}; pg8::StaticOrder S; S.init(TOK, DM, G, bx);
        pg8::EpiRes E{F.in[I_X], (float*)(ws + WS_S6), (pg8::bf16_t*)(ws + WS_S0), F.in[I_GMQ], (float*)(ws + WS_PS1)};
        pg8::gemm_phase<pg8::EpiRes, pg8::StaticOrder, false, true>(F.lds + RING_OFF, g, S, E);
        if (BOTH(5)) GRID_BAR();
    }

    if (IN(6)) {
        pg8::Gemm g{(const pg8::bf16_t*)(ws + WS_S0), (const pg8::bf16_t*)(ws + WS_WMQ), TOK, DM, DM}; pg8::StaticOrder S; S.init(TOK, DM, G, bx);
        pg8::EpiRowScale E{(const float*)(ws + WS_PS1), (pg8::bf16_t*)(ws + WS_S1), 0.04419417382415922f, EPS};
        pg8::gemm_phase<pg8::EpiRowScale, pg8::StaticOrder, false, true>(F.lds + RING_OFF, g, S, E);
        if (BOTH(6)) GRID_BAR();
    }

    if (IN(7)) {
        for (int u = F.vcu * 2; u < 512; u += 2 * G) { xattn_unit(F, u); if (u + 1 < 512) xattn_unit(F, u + 1); }
        if (BOTH(7)) GRID_BAR();
    }

#ifndef DBG_SKIP_CROSS
#define DBG_SKIP_CROSS 0
#endif
    if (IN(8) && !DBG_SKIP_CROSS) {
        pg8::Gemm g{(const pg8::bf16_t*)(ws + WS_S0), (const pg8::bf16_t*)(ws + WS_WMO), TOK, DM, DM}; pg8::StaticOrder S; S.init(TOK, DM, G, bx);
        pg8::EpiRes E{(const float*)(ws + WS_S6), (float*)(ws + WS_S6), (pg8::bf16_t*)(ws + WS_S1), F.in[I_GFFN], (float*)(ws + WS_PS2)};
        pg8::gemm_phase<pg8::EpiRes, pg8::StaticOrder, false, true>(F.lds + RING_OFF, g, S, E);
        if (BOTH(8)) GRID_BAR();
    }

    if (IN(9)) {
        pg8::Gemm g{(const pg8::bf16_t*)(ws + WS_S1), (const pg8::bf16_t*)(ws + WS_WPQ), TOK, DM, DM}; pg8::StaticOrder S; S.init(TOK, DM, G, bx);
        pg8::EpiRowScale E{(const float*)(ws + WS_PS2), (pg8::bf16_t*)(ws + WS_S0), 1.0f, EPS};
        pg8::gemm_phase<pg8::EpiRowScale, pg8::StaticOrder, false, true>(F.lds + RING_OFF, g, S, E);
        if (BOTH(9)) GRID_BAR();
    }

    if (IN(10)) {
        for (int u = F.vcu * 4; u < 1024; u += 4 * G) { for (int k = 0; k < 4; ++k) if (u + k < 1024) score_unit(F, u + k); }
        if (BOTH(10)) GRID_BAR();
    }

    if (IN(11)) {
        const int gw = F.vcu * NWAVES + F.wave, NGW = G * NWAVES;
        for (int q = gw; q < TOK * 8; q += NGW) route_item(F, q);
        if (BOTH(11)) GRID_BAR();
    }

    if (IN(12)) {
        const int gw = F.vcu * NWAVES + F.wave, NGW = G * NWAVES;
#if defined(DBG_PROBE)
        { const bf16* src = (const bf16*)(ws + DBG_PROBE_OFF);
          for (int t = gw; t < TOK; t += NGW) for (int c = F.lane; c < DM; c += 64) F.out[(size_t)t * DM + c] = bflo((unsigned)src[(size_t)t * DBG_PROBE_PITCH + (c % DBG_PROBE_PITCH)]); }
#elif defined(DBG_PROBE_P1)
        { const bf16* QKp = (const bf16*)(ws + WS_S2); const bf16* VTp = (const bf16*)(ws + WS_S6); const bf16* ZUp = (const bf16*)(ws + WS_S1); const bf16* ZVp = (const bf16*)(ws + WS_S1 + 16 * MiB); const bf16* GABp = (const bf16*)(ws + WS_S4);
          const bf16* KMp = (const bf16*)(ws + WS_KM);
          for (int t = gw; t < TOK; t += NGW) for (int c = F.lane; c < DM; c += 64) { float v = 0.f;
            if (DBG_PROBE_P1 & 1) v += bflo((unsigned)QKp[(size_t)t * 2048 + c]);
            if (DBG_PROBE_P1 & 2) v += bflo((unsigned)VTp[(size_t)t * 1024 + (c & 1023)]);
            if (DBG_PROBE_P1 & 4) v += bflo((unsigned)ZUp[(size_t)t * 1024 + (c & 1023)]);
            if (DBG_PROBE_P1 & 256) v += bflo((unsigned)ZVp[(size_t)t * 1024 + (c & 1023)]);
            if (DBG_PROBE_P1 & 8) v += bflo((unsigned)GABp[(size_t)t * 4096 + c]) + bflo((unsigned)GABp[(size_t)t * 4096 + 2048 + c]);
            if (DBG_PROBE_P1 & 16) v += bflo((unsigned)KMp[(size_t)(t & 1023) * 2048 + c]);
            if (DBG_PROBE_P1 & 32) v += bflo((unsigned)((const bf16*)(ws + WS_S0))[(size_t)t * 2048 + c]);
            if (DBG_PROBE_P1 & 64) v += bflo((unsigned)((const bf16*)(ws + WS_WIN))[(size_t)t * 2048 + c]);
            if (DBG_PROBE_P1 & 128) v += bflo((unsigned)((const bf16*)(ws + WS_MN))[(size_t)(t & 511) * 2048 + c]) + bflo((unsigned)((const bf16*)(ws + WS_WMKV))[(size_t)(t & 4095) * 2048 + c]);
            F.out[(size_t)t * DM + c] = v; } }
#else
        for (int t = gw; t < TOK; t += NGW) peer_token(F, t);
#endif
    }
#undef IN
#undef BOTH
}

extern "C" void kernel_launch(void* const* d_in, const int* in_sizes, int n_in, void* d_out, int out_size, void* d_ws, size_t ws_size, hipStream_t stream) {
    static int grid = 0;
    if (grid == 0) {
        if (n_in != 23 || out_size != TOK * DM || ws_size < WS_END) { fprintf(stderr, "kernel_launch: unexpected shapes (n_in %d, out %d, ws %zu)\n", n_in, out_size, ws_size); grid = -1; return; }
        int dev = 0, cus = 0, per_cu = 0;
        if (hipGetDevice(&dev) != hipSuccess || hipDeviceGetAttribute(&cus, hipDeviceAttributeMultiprocessorCount, dev) != hipSuccess) { grid = -1; return; }
        if (hipFuncSetAttribute((const void*)mk_fwd, hipFuncAttributeMaxDynamicSharedMemorySize, LDS_BYTES) != hipSuccess) { fprintf(stderr, "kernel_launch: hipFuncSetAttribute failed\n"); grid = -1; return; }
        if (hipOccupancyMaxActiveBlocksPerMultiprocessor(&per_cu, (const void*)mk_fwd, NWAVES * 64, LDS_BYTES) != hipSuccess || per_cu < 1) { fprintf(stderr, "kernel_launch: occupancy query reports %d blocks per CU\n", per_cu); }
        (void)hipGetLastError();
        grid = cus;
    }
    if (grid < 0) return;
    if (hipMemsetAsync((char*)d_ws + WS_CTL, 0, CTL_ZERO_BYTES, stream) != hipSuccess) return;
    Args a{};
    for (int i = 0; i < 23; ++i) a.in[i] = (const float*)d_in[i];
    a.out = (float*)d_out; a.ws = (unsigned char*)d_ws; a.pad = 0;
    for (int li = 0; li < N_LAUNCHES; ++li) {
        a.ph_lo = (N_LAUNCHES == 1) ? 0 : li; a.ph_hi = (N_LAUNCHES == 1) ? NPH : li + 1; a.li = li;
        hipLaunchKernelGGL(mk_fwd, dim3(grid), dim3(NWAVES * 64), LDS_BYTES, stream, a);
        if (hipPeekAtLastError() != hipSuccess) { fprintf(stderr, "kernel_launch: launch %d failed\n", li); break; }
    }
}
```

```cpp
#include <hip/hip_runtime.h>
#include <cstdio>
#include <cstdint>
#define MK_N_LAUNCHES 1
namespace pg8 {
#define PG8_LAS __attribute__((address_space(3)))
typedef unsigned short bf16_t;
typedef short bf16x8 __attribute__((ext_vector_type(8)));
typedef float f32x4 __attribute__((ext_vector_type(4)));
typedef unsigned u32x4 __attribute__((ext_vector_type(4)));
constexpr int BM = 256, BK = 64, HALF = 128, HTB = HALF * BK * 2  , STAGE_BYTES = 8 * HTB, NXCD = 8, WGM = 8;

__host__ __device__ __forceinline__ int lds_byte(int r, int c) { const int st = (r >> 4) * 2 + (c >> 5), rr = r & 15, cc = c & 31, ob = rr * 64 + cc * 2; return st * 1024 + (ob ^ (((ob >> 9) & 1) << 5)); }
__host__ __device__ __forceinline__ void stage_rc(int b, int& R, int& C) { const int st = b / 1024, sb = b % 1024, swz = sb ^ (((sb >> 9) & 1) << 5); R = (st >> 1) * 16 + swz / 64; C = (st & 1) * 32 + (swz % 64) / 2; }
__host__ __device__ __forceinline__ int perm32(int rho) { const int n = rho >> 4, i = rho & 15; return 8 * (i >> 2) + 4 * n + (i & 3); }

struct Unit { int pm, pn; int aoff = 0, boff = 0, aux = 0; };
struct Gemm { const bf16_t* A; const bf16_t* Bt; int M, N, K; int lda = 0, ldb = 0; };

struct StaticOrder {
    int nM, nN, nwg, G, c;
    __host__ __device__ void init(int M, int N, int G_, int c_) { nM = M / BM; nN = N / BM; nwg = nM * nN; G = G_; c = c_; }
    __host__ __device__ bool next(int i, Unit& u) const {
        const long L = (long)i * G + c; if (L >= nwg) return false;
        int wgid = (int)L; { const int q = nwg / NXCD, r = nwg % NXCD, xcd = wgid % NXCD, off = wgid / NXCD; wgid = (xcd < r ? xcd * (q + 1) : r * (q + 1) + (xcd - r) * q) + off; }
        const int nig = WGM * nN, gid = wgid / nig, fm = gid * WGM, gsz = (nM - fm) < WGM ? (nM - fm) : WGM;
        u.pm = fm + ((wgid % nig) % gsz); u.pn = (wgid % nig) / gsz; return true;
    }
    __device__ __forceinline__ void a_ready(const Unit&) const {}
    __device__ __forceinline__ void done(const Unit&) const {}
};

typedef __bf16 bf16x2_cv __attribute__((ext_vector_type(2)));
typedef float f32x2_cv __attribute__((ext_vector_type(2)));
__device__ __forceinline__ unsigned cvt_pk_bf16(float lo, float hi) { const f32x2_cv v = {lo, hi}; const bf16x2_cv b = __builtin_convertvector(v, bf16x2_cv); return __builtin_bit_cast(unsigned, b); }
typedef float f32x2 __attribute__((ext_vector_type(2)));
__device__ __forceinline__ f32x2 gelu_pk(f32x2 v) {
    const f32x2 av = __builtin_elementwise_abs(v), d = av * 0.2316418882f + 1.0f;
    f32x2 t; t.x = __builtin_amdgcn_rcpf(d.x); t.y = __builtin_amdgcn_rcpf(d.y);
    f32x2 q = t * 0.5307027145f + (-0.7265760135f); q = q * t + 0.7107068705f; q = q * t + (-0.142248368f); q = q * t + 0.127414796f; q = q * t;
    const f32x2 s = (v * v) * (-0.72134752044f);
    f32x2 e; e.x = __builtin_amdgcn_exp2f(s.x); e.y = __builtin_amdgcn_exp2f(s.y);
    const f32x2 m = v * (q * e), r = v - m;
    f32x2 o; o.x = v.x < 0.f ? m.x : r.x; o.y = v.y < 0.f ? m.y : r.y; return o;
}
__device__ __forceinline__ float sigmoid1(float x) { return __builtin_amdgcn_rcpf(1.0f + __expf(-x)); }
__device__ __forceinline__ u32x4 pack8(const f32x4& v0, const f32x4& v1) { u32x4 w; w.x = cvt_pk_bf16(v0[0], v0[1]); w.y = cvt_pk_bf16(v0[2], v0[3]); w.z = cvt_pk_bf16(v1[0], v1[1]); w.w = cvt_pk_bf16(v1[2], v1[3]); return w; }
__device__ __forceinline__ float bf_lo(unsigned w) { return __builtin_bit_cast(float, w << 16); }
__device__ __forceinline__ float bf_hi(unsigned w) { return __builtin_bit_cast(float, w & 0xffff0000u); }
__device__ __forceinline__ void unpack8(const u32x4& w, f32x4& v0, f32x4& v1) { v0 = (f32x4){bf_lo(w.x), bf_hi(w.x), bf_lo(w.y), bf_hi(w.y)}; v1 = (f32x4){bf_lo(w.z), bf_hi(w.z), bf_lo(w.w), bf_hi(w.w)}; }

#ifndef DBG_NO_T1
#define DBG_NO_T1 0
#endif
#define PG8_THROTTLE() asm volatile("s_waitcnt vmcnt(24)" ::: "memory")
typedef unsigned u32x2e __attribute__((ext_vector_type(2)));
__device__ __forceinline__ u32x2e pack8_fp8(const f32x4& v0, const f32x4& v1) { int a = 0, b = 0;
    a = __builtin_amdgcn_cvt_pk_fp8_f32(v0[0], v0[1], a, false); a = __builtin_amdgcn_cvt_pk_fp8_f32(v0[2], v0[3], a, true);
    b = __builtin_amdgcn_cvt_pk_fp8_f32(v1[0], v1[1], b, false); b = __builtin_amdgcn_cvt_pk_fp8_f32(v1[2], v1[3], b, true); return (u32x2e){(unsigned)a, (unsigned)b}; }
#define PG8_EPI_LOOP(...) \
    _Pragma("unroll") for (int ai = 0; ai < 2; ++ai) _Pragma("unroll") for (int m = 0; m < 4; ++m) { \
        const int row = u.pm * BM + ai * HALF + wr * 64 + m * 16 + fr; (void)row; \
        _Pragma("unroll") for (int bj = 0; bj < 2; ++bj) { \
            const int col = u.pn * BM + bj * HALF + wc * 32 + 8 * fq; (void)col; \
            f32x4 v0 = acc[ai][bj][m][0], v1 = acc[ai][bj][m][1]; __VA_ARGS__ } }

struct EpiIn {
    static constexpr bool PERM = true, AFTER_DRAIN = false, MIDHOOK = false;
    bf16_t* ZU;
    bf16_t* ZVT;
    bf16_t* QK;
    bf16_t* VT;
    bf16_t* GAB;
    float qscale;
    float* PSV;
    float s8;
    __device__ __forceinline__ void operator()(const f32x4 (&acc)[2][2][4][2], const Unit& u, int wr, int wc, int fr, int fq) const {
        const int pn = u.pn;
        if (pn < 4) {
            PG8_EPI_LOOP({ f32x2 a = gelu_pk((f32x2){v0[0], v0[1]}), b = gelu_pk((f32x2){v0[2], v0[3]}), c = gelu_pk((f32x2){v1[0], v1[1]}), d = gelu_pk((f32x2){v1[2], v1[3]});
                v0 = (f32x4){a.x, a.y, b.x, b.y}; v1 = (f32x4){c.x, c.y, d.x, d.y};
                *(u32x4*)(ZU + (size_t)row * 1024 + col) = pack8(v0, v1); })
        } else if (pn < 8) {
#pragma unroll
            for (int ai = 0; ai < 2; ++ai)
#pragma unroll
                for (int m = 0; m < 4; ++m) { const int row = u.pm * BM + ai * HALF + wr * 64 + m * 16 + fr; float s = 0.f, q = 0.f;
#pragma unroll
                    for (int bj = 0; bj < 2; ++bj) { const int col = u.pn * BM + bj * HALF + wc * 32 + 8 * fq; const f32x4 v0 = acc[ai][bj][m][0], v1 = acc[ai][bj][m][1];
                        f32x2 a = gelu_pk((f32x2){v0[0], v0[1]}), b = gelu_pk((f32x2){v0[2], v0[3]}), cc = gelu_pk((f32x2){v1[0], v1[1]}), d = gelu_pk((f32x2){v1[2], v1[3]});
                        const u32x4 w = pack8((f32x4){a.x, a.y, b.x, b.y}, (f32x4){cc.x, cc.y, d.x, d.y});
                        const unsigned w4[4] = {w.x, w.y, w.z, w.w};
#pragma unroll
                        for (int e = 0; e < 4; ++e) { const float x0 = bf_lo(w4[e]), x1 = bf_hi(w4[e]); s += x0 + x1; q += x0 * x0 + x1 * x1; }
                        bf16_t* p = ZVT + ((size_t)(row >> 7) * 1024 + (col - 1024)) * 128 + (row & 127);
                        p[0 * 128] = (bf16_t)(w.x & 0xffffu); p[1 * 128] = (bf16_t)(w.x >> 16); p[2 * 128] = (bf16_t)(w.y & 0xffffu); p[3 * 128] = (bf16_t)(w.y >> 16);
                        p[4 * 128] = (bf16_t)(w.z & 0xffffu); p[5 * 128] = (bf16_t)(w.z >> 16); p[6 * 128] = (bf16_t)(w.w & 0xffffu); p[7 * 128] = (bf16_t)(w.w >> 16); PG8_THROTTLE(); }
                    s += __shfl_xor(s, 16); s += __shfl_xor(s, 32); q += __shfl_xor(q, 16); q += __shfl_xor(q, 32);
                    if (fq == 0) { float* ps = PSV + ((size_t)row * 16 + (pn - 4) * 4 + wc) * 2; ps[0] = s; ps[1] = q; } }
        } else if (pn < 16) {
            const float sc = (pn < 12 ? qscale : 1.0f) * s8;
            PG8_EPI_LOOP({ v0 = v0 * sc; v1 = v1 * sc; *(u32x4*)(QK + (size_t)row * 2048 + (col - 2048)) = pack8(v0, v1); })
        } else if (pn < 20) {
            PG8_EPI_LOOP({ const u32x4 w = pack8(v0 * s8, v1 * s8); const int c = col - 4096;
                bf16_t* p = VT + ((size_t)((row >> 12) * 1024 + c)) * 4096 + (row & 4095);
                p[0 * 4096] = (bf16_t)(w.x & 0xffffu); p[1 * 4096] = (bf16_t)(w.x >> 16); p[2 * 4096] = (bf16_t)(w.y & 0xffffu); p[3 * 4096] = (bf16_t)(w.y >> 16);
                p[4 * 4096] = (bf16_t)(w.z & 0xffffu); p[5 * 4096] = (bf16_t)(w.z >> 16); p[6 * 4096] = (bf16_t)(w.w & 0xffffu); p[7 * 4096] = (bf16_t)(w.w >> 16); PG8_THROTTLE(); })
        } else {
            PG8_EPI_LOOP({ v0 = v0 * s8; v1 = v1 * s8; v0 = (f32x4){sigmoid1(v0[0]), sigmoid1(v0[1]), sigmoid1(v0[2]), sigmoid1(v0[3])}; v1 = (f32x4){sigmoid1(v1[0]), sigmoid1(v1[1]), sigmoid1(v1[2]), sigmoid1(v1[3])};
                *(u32x4*)(GAB + (size_t)row * 4096 + (col - 5120)) = pack8(v0, v1); })
        }
    }
};
struct EpiKV {
    static constexpr bool PERM = true, AFTER_DRAIN = false, MIDHOOK = false;
    bf16_t* KVM; float s8;
    __device__ __forceinline__ void operator()(const f32x4 (&acc)[2][2][4][2], const Unit& u, int wr, int wc, int fr, int fq) const {
        PG8_EPI_LOOP({ *(u32x4*)(KVM + (size_t)row * 4096 + col) = pack8(v0 * s8, v1 * s8); })
    }
};
template <bool O8> struct EpiPre {
    static constexpr bool PERM = true, AFTER_DRAIN = false, MIDHOOK = false;
    bf16_t* O; int ldc, rs_pm, rs_pn, rs_aux, cs_pn, cs_aux; float oscale;
    __device__ __forceinline__ void operator()(const f32x4 (&acc)[2][2][4][2], const Unit& u, int wr, int wc, int fr, int fq) const {
        const int r0 = u.pm * rs_pm + u.pn * rs_pn + u.aux * rs_aux, c0 = u.pn * cs_pn + u.aux * cs_aux;
#pragma unroll
        for (int ai = 0; ai < 2; ++ai)
#pragma unroll
            for (int m = 0; m < 4; ++m)
#pragma unroll
                for (int bj = 0; bj < 2; ++bj) { const int r = r0 + ai * HALF + wr * 64 + m * 16 + fr, cc = c0 + bj * HALF + wc * 32 + 8 * fq;
                    if (O8) *(u32x2e*)((unsigned char*)O + (size_t)r * ldc + cc) = pack8_fp8(acc[ai][bj][m][0] * oscale, acc[ai][bj][m][1] * oscale);
                    else *(u32x4*)(O + (size_t)r * ldc + cc) = pack8(acc[ai][bj][m][0], acc[ai][bj][m][1]); }
    }
};
struct EpiSoftmax {
    static constexpr bool PERM = true, AFTER_DRAIN = true, MIDHOOK = false;
    const float* PS; bf16_t* P; float scale, eps, pscale;
    __device__ __forceinline__ void operator()(const f32x4 (&)[2][2][4][2], const Unit&, int, int, int, int) const {}
    __device__ __forceinline__ void fused(f32x4 (&acc)[2][2][4][2], const Unit& u, int wr, int wc, int fr, int fq, PG8_LAS unsigned char* lds, int wid, int lane) const {
        PG8_LAS float* RMX = (PG8_LAS float*)lds;
        PG8_LAS float* RSM = (PG8_LAS float*)(lds + 4096);
        float mx[2][4];
#pragma unroll
        for (int aim = 0; aim < 4; ++aim) { const int ai = aim >> 1, m0 = (aim & 1) * 2;
            f32x4 t[2][8];
#pragma unroll
            for (int mm = 0; mm < 2; ++mm) { const f32x4* ps = (const f32x4*)(PS + (size_t)(u.pm * BM + ai * HALF + wr * 64 + (m0 + mm) * 16 + fr) * 32);
#pragma unroll
                for (int i = 0; i < 8; ++i) t[mm][i] = ps[i]; }
            asm volatile("" ::: "memory");
#pragma unroll
            for (int mm = 0; mm < 2; ++mm) { const int m = m0 + mm; float s = 0.f;
#pragma unroll
                for (int i = 0; i < 8; ++i) s += (t[mm][i][0] + t[mm][i][1]) + (t[mm][i][2] + t[mm][i][3]);
                const float rs = __builtin_amdgcn_rsqf(s * (1.0f / 2048.0f) + eps) * scale; float x = -1e30f;
#pragma unroll
                for (int bj = 0; bj < 2; ++bj)
#pragma unroll
                    for (int n = 0; n < 2; ++n) { acc[ai][bj][m][n] = acc[ai][bj][m][n] * rs; const f32x4 v = acc[ai][bj][m][n]; x = fmaxf(x, fmaxf(fmaxf(v[0], v[1]), fmaxf(v[2], v[3]))); }
                x = fmaxf(x, __shfl_xor(x, 16)); x = fmaxf(x, __shfl_xor(x, 32));
                if (fq == 0) RMX[(ai * HALF + wr * 64 + m * 16 + fr) * 4 + wc] = x;
                mx[ai][m] = x; }
        }
        asm volatile("s_waitcnt lgkmcnt(0)" ::: "memory"); __builtin_amdgcn_s_barrier(); asm volatile("" ::: "memory");
#pragma unroll
        for (int ai = 0; ai < 2; ++ai)
#pragma unroll
            for (int m = 0; m < 4; ++m) { const int r = ai * HALF + wr * 64 + m * 16 + fr; const f32x4 q = *(const PG8_LAS f32x4*)(RMX + r * 4);
                const float mxr = fmaxf(fmaxf(q[0], q[1]), fmaxf(q[2], q[3])); float sm = 0.f;
#pragma unroll
                for (int bj = 0; bj < 2; ++bj)
#pragma unroll
                    for (int n = 0; n < 2; ++n) { f32x4 v = acc[ai][bj][m][n]; v = (f32x4){__expf(v[0] - mxr), __expf(v[1] - mxr), __expf(v[2] - mxr), __expf(v[3] - mxr)}; acc[ai][bj][m][n] = v; sm += (v[0] + v[1]) + (v[2] + v[3]); }
                sm += __shfl_xor(sm, 16); sm += __shfl_xor(sm, 32);
                if (fq == 0) RSM[r * 4 + wc] = sm; }
        asm volatile("s_waitcnt lgkmcnt(0)" ::: "memory"); __builtin_amdgcn_s_barrier(); asm volatile("" ::: "memory");
#pragma unroll
        for (int ai = 0; ai < 2; ++ai)
#pragma unroll
            for (int m = 0; m < 4; ++m) { const int r = ai * HALF + wr * 64 + m * 16 + fr; const f32x4 q = *(const PG8_LAS f32x4*)(RSM + r * 4);
                const float inv = __builtin_amdgcn_rcpf((q[0] + q[1]) + (q[2] + q[3])) * pscale;
#pragma unroll
                for (int bj = 0; bj < 2; ++bj) *(u32x2e*)((unsigned char*)P + (size_t)(u.pm * BM + r) * 1024 + u.pn * BM + bj * HALF + wc * 32 + 8 * fq) = pack8_fp8(acc[ai][bj][m][0] * inv, acc[ai][bj][m][1] * inv); }
    }
};
template <size_t GAB_OFF, size_t T1_OFF, size_t MRG_OFF> struct EpiUp2 {
    static constexpr bool PERM = true, AFTER_DRAIN = false, MIDHOOK = false, CHAIN = true;
    unsigned char* wsb; float bscale, ascale;
    __device__ __forceinline__ void operator()(const f32x4 (&acc_)[2][2][4][2], const Unit& u, int wr, int wc, int fr, int fq) const {
        f32x4 (&acc)[2][2][4][2] = const_cast<f32x4 (&)[2][2][4][2]>(acc_);
        const bf16_t* GAB = (const bf16_t*)(wsb + GAB_OFF); bf16_t* MRG = (bf16_t*)(wsb + MRG_OFF);
        const bool second = u.aux != 0;
#pragma unroll
        for (int ai = 0; ai < 2; ++ai) {
            u32x4 ga[4][2], gb[4][2];
#pragma unroll
            for (int m = 0; m < 4; ++m)
#pragma unroll
                for (int bj = 0; bj < 2; ++bj) { const int row = u.pm * BM + ai * HALF + wr * 64 + m * 16 + fr, col = u.pn * BM + bj * HALF + wc * 32 + 8 * fq;
                    gb[m][bj] = *(const u32x4*)(GAB + (size_t)row * 4096 + 2048 + col);
                    ga[m][bj] = second ? (u32x4){0u, 0u, 0u, 0u} : *(const u32x4*)(GAB + (size_t)row * 4096 + col); }
            asm volatile("" ::: "memory");
#pragma unroll
            for (int m = 0; m < 4; ++m)
#pragma unroll
                for (int bj = 0; bj < 2; ++bj) { const int row = u.pm * BM + ai * HALF + wr * 64 + m * 16 + fr, col = u.pn * BM + bj * HALF + wc * 32 + 8 * fq;
                    f32x4 b0, b1; unpack8(gb[m][bj], b0, b1);
#pragma unroll
                    for (int e = 0; e < 4; ++e) { b0[e] = fmaxf(b0[e], 1e-6f) * bscale; b1[e] = fmaxf(b1[e], 1e-6f) * bscale; }
                    if (second) *(u32x2e*)((unsigned char*)MRG + (size_t)row * 2048 + col) = pack8_fp8(acc[ai][bj][m][0] * b0 * 16.0f, acc[ai][bj][m][1] * b1 * 16.0f);
                    else { f32x4 a0, a1; unpack8(ga[m][bj], a0, a1);
#pragma unroll
                        for (int e = 0; e < 4; ++e) { acc[ai][bj][m][0][e] *= a0[e] * ascale * __builtin_amdgcn_rcpf(b0[e]); acc[ai][bj][m][1][e] *= a1[e] * ascale * __builtin_amdgcn_rcpf(b1[e]); } } }
            asm volatile("" ::: "memory");
        }
    }
};
template <bool AN8, bool BASE16> struct EpiRes {
    static constexpr bool PERM = true, AFTER_DRAIN = false, MIDHOOK = false;
    const void* base; bf16_t* H; bf16_t* AN; const float* gain; float* PS; float accscale, an_scale;
    __device__ __forceinline__ void operator()(const f32x4 (&acc)[2][2][4][2], const Unit& u, int wr, int wc, int fr, int fq) const {
        f32x4 g[2][2];
#pragma unroll
        for (int bj = 0; bj < 2; ++bj) { const int col = u.pn * BM + bj * HALF + wc * 32 + 8 * fq; g[bj][0] = *(const f32x4*)(gain + col); g[bj][1] = *(const f32x4*)(gain + col + 4); }
#pragma unroll
        for (int aim = 0; aim < 4; ++aim) { const int ai = aim >> 1, m0 = (aim & 1) * 2;
            f32x4 b[2][2][2];
#pragma unroll
            for (int mm = 0; mm < 2; ++mm)
#pragma unroll
                for (int bj = 0; bj < 2; ++bj) { const size_t off = (size_t)(u.pm * BM + ai * HALF + wr * 64 + (m0 + mm) * 16 + fr) * 2048 + u.pn * BM + bj * HALF + wc * 32 + 8 * fq;
                    if (BASE16) { unpack8(*(const u32x4*)((const bf16_t*)base + off), b[mm][bj][0], b[mm][bj][1]); }
                    else { b[mm][bj][0] = __builtin_nontemporal_load((const f32x4*)((const float*)base + off)); b[mm][bj][1] = __builtin_nontemporal_load((const f32x4*)((const float*)base + off + 4)); } }
            asm volatile("" ::: "memory");
#pragma unroll
            for (int mm = 0; mm < 2; ++mm) { const int m = m0 + mm;
                const int row = u.pm * BM + ai * HALF + wr * 64 + m * 16 + fr; float ss = 0.f;
#pragma unroll
                for (int bj = 0; bj < 2; ++bj) { const int col = u.pn * BM + bj * HALF + wc * 32 + 8 * fq; const size_t off = (size_t)row * 2048 + col;
                    const f32x4 h0 = acc[ai][bj][m][0] * accscale + b[mm][bj][0], h1 = acc[ai][bj][m][1] * accscale + b[mm][bj][1];
                    *(u32x4*)(H + off) = pack8(h0, h1);
                    ss += (h0[0] * h0[0] + h0[1] * h0[1]) + (h0[2] * h0[2] + h0[3] * h0[3]) + (h1[0] * h1[0] + h1[1] * h1[1]) + (h1[2] * h1[2] + h1[3] * h1[3]);
                    if (AN8) *(u32x2e*)((unsigned char*)AN + off) = pack8_fp8(h0 * g[bj][0] * an_scale, h1 * g[bj][1] * an_scale);
                    else *(u32x4*)(AN + off) = pack8(h0 * g[bj][0], h1 * g[bj][1]); }
                ss += __shfl_xor(ss, 16); ss += __shfl_xor(ss, 32);
                if (fq == 0) PS[(size_t)row * 32 + u.pn * 4 + wc] = ss;
            }
            asm volatile("" ::: "memory");
        }
    }
};
struct EpiRowScale {
    static constexpr bool PERM = true, AFTER_DRAIN = false, MIDHOOK = false;
    const float* PS; bf16_t* O; float scale, eps;
    __device__ __forceinline__ void operator()(const f32x4 (&acc)[2][2][4][2], const Unit& u, int wr, int wc, int fr, int fq) const {
#pragma unroll
        for (int aim = 0; aim < 4; ++aim) { const int ai = aim >> 1, m0 = (aim & 1) * 2;
            f32x4 t[2][8];
#pragma unroll
            for (int mm = 0; mm < 2; ++mm) { const f32x4* ps = (const f32x4*)(PS + (size_t)(u.pm * BM + ai * HALF + wr * 64 + (m0 + mm) * 16 + fr) * 32);
#pragma unroll
                for (int i = 0; i < 8; ++i) t[mm][i] = ps[i]; }
            asm volatile("" ::: "memory");
#pragma unroll
            for (int mm = 0; mm < 2; ++mm) { const int m = m0 + mm;
                const int row = u.pm * BM + ai * HALF + wr * 64 + m * 16 + fr; float s = 0.f;
#pragma unroll
                for (int i = 0; i < 8; ++i) s += (t[mm][i][0] + t[mm][i][1]) + (t[mm][i][2] + t[mm][i][3]);
                const float rs = __builtin_amdgcn_rsqf(s * (1.0f / 2048.0f) + eps) * scale;
#pragma unroll
                for (int bj = 0; bj < 2; ++bj) { const int col = u.pn * BM + bj * HALF + wc * 32 + 8 * fq;
                    *(u32x4*)(O + (size_t)row * 2048 + col) = pack8(acc[ai][bj][m][0] * rs, acc[ai][bj][m][1] * rs); }
            }
        }
    }
};
struct EpiScore {
    static constexpr bool PERM = true, AFTER_DRAIN = false, MIDHOOK = false;
    const float* PS; float* SCT; float eps;
    __device__ __forceinline__ void operator()(const f32x4 (&acc)[2][2][4][2], const Unit& u, int wr, int wc, int fr, int fq) const {
#pragma unroll
        for (int aim = 0; aim < 4; ++aim) { const int ai = aim >> 1, m0 = (aim & 1) * 2;
            f32x4 t[2][8];
#pragma unroll
            for (int mm = 0; mm < 2; ++mm) { const f32x4* ps = (const f32x4*)(PS + (size_t)(u.pm * BM + ai * HALF + wr * 64 + (m0 + mm) * 16 + fr) * 32);
#pragma unroll
                for (int i = 0; i < 8; ++i) t[mm][i] = ps[i]; }
            asm volatile("" ::: "memory");
#pragma unroll
            for (int mm = 0; mm < 2; ++mm) { const int m = m0 + mm;
                const int row = u.pm * BM + ai * HALF + wr * 64 + m * 16 + fr; float s = 0.f;
#pragma unroll
                for (int i = 0; i < 8; ++i) s += (t[mm][i][0] + t[mm][i][1]) + (t[mm][i][2] + t[mm][i][3]);
                const float rs = __builtin_amdgcn_rsqf(s * (1.0f / 2048.0f) + eps);
#pragma unroll
                for (int bj = 0; bj < 2; ++bj) { const int key0 = wc * 32 + 8 * fq;
                    float* dst = SCT + ((size_t)(key0 >> 2) * (8192 * 16) + (size_t)(u.pn * 2 + bj) * 8192 + row) * 4;
                    *(f32x4*)dst = acc[ai][bj][m][0] * rs; *(f32x4*)(dst + (size_t)(8192 * 16) * 4) = acc[ai][bj][m][1] * rs; }
            }
        }
    }
};
struct EpiPlain {
    static constexpr bool PERM = true, AFTER_DRAIN = false, MIDHOOK = false;
    bf16_t* O; int ldc;
    __device__ __forceinline__ void operator()(const f32x4 (&acc)[2][2][4][2], const Unit& u, int wr, int wc, int fr, int fq) const {
        PG8_EPI_LOOP({ *(u32x4*)(O + (size_t)row * ldc + col) = pack8(v0, v1); })
    }
};
template <int WHICH> struct PreOrder {
    int c, lo;
    __host__ __device__ bool next(int i, Unit& u) const { const int idx = c - lo; if (i != 0 || idx < 0 || idx >= 64) return false;
        const int bh = idx >> 3, t = idx & 7, b = bh >> 2, h = bh & 3; u.aux = h;
        if (WHICH == 0) { u.pm = b; u.pn = t; u.aoff = h * 512; u.boff = h * 512; } else { u.pm = t; u.pn = b; u.aoff = h * 512; u.boff = 2048 + h * 512; }
        return true; }
    __device__ __forceinline__ void a_ready(const Unit&) const {}
    __device__ __forceinline__ void done(const Unit&) const {}
};
struct ScoreOrder {
    int c;
    __host__ __device__ bool next(int i, Unit& u) const { if (i != 0 || c >= 128) return false; const int idx = (c & 7) * 16 + (c >> 3); u.pm = idx >> 2; u.pn = idx & 3; u.aoff = 0; u.boff = u.pm >= 16 ? 1024 * 1024 : 0; return true; }
    __device__ __forceinline__ void a_ready(const Unit&) const {}
    __device__ __forceinline__ void done(const Unit&) const {}
};
struct BatchOrder {
    StaticOrder S; int boff_b1;
    __host__ __device__ bool next(int i, Unit& u) const { if (!S.next(i, u)) return false; u.aoff = 0; u.boff = u.pm >= 16 ? boff_b1 : 0; return true; }
    __device__ __forceinline__ void a_ready(const Unit&) const {}
    __device__ __forceinline__ void done(const Unit&) const {}
};
struct UpOrder {
    StaticOrder S; int aoff_b, boff_b;
    __host__ __device__ bool next(int i, Unit& u) const { if (!S.next(i >> 1, u)) return false; u.aux = i & 1; u.aoff = (i & 1) ? aoff_b : 0; u.boff = (i & 1) ? boff_b : 0; return true; }
    __device__ __forceinline__ void a_ready(const Unit&) const {}
    __device__ __forceinline__ void done(const Unit&) const {}
};
template <bool F8PART> struct SplitInOrder {
    StaticOrder S;
    __host__ __device__ bool next(int i, Unit& u) const { if (!S.next(i, u)) return false; u.aoff = 0;
        if (F8PART) { u.pn += 8; u.boff = -8 * 256 * 1024; } else { u.boff = 0; } return true; }
    __device__ __forceinline__ void a_ready(const Unit&) const {}
    __device__ __forceinline__ void done(const Unit&) const {}
};
struct ShiftedOrder {
    StaticOrder S; bool on;
    __host__ __device__ void init(int M, int N, int G_, int c_, int first) { on = c_ >= first; S.init(M, N, G_, on ? c_ - first : 0); }
    __host__ __device__ bool next(int i, Unit& u) const { return on && S.next(i, u); }
    __device__ __forceinline__ void a_ready(const Unit&) const {}
    __device__ __forceinline__ void done(const Unit&) const {}
};

template <class E, class = void> struct EpiChain { static constexpr bool value = false; };
template <class E> struct EpiChain<E, decltype((void)E::CHAIN)> { static constexpr bool value = E::CHAIN; };
template <class Epi, class Sched, bool ALIGN_EPI = false, bool SP2 = false, bool F8 = false>
__device__ __forceinline__ void gemm_phase(PG8_LAS unsigned char* lds, const Gemm g, const Sched& S, const Epi& E) {
    const int tid = threadIdx.x, wid = __builtin_amdgcn_readfirstlane(tid >> 6), lane = tid & 63, wr = wid >> 2, wc = wid & 3, fr = lane & 15, fq = lane >> 4;
    const int K = g.K, nt = K / BK, lda = g.lda ? g.lda : K, ldb = g.ldb ? g.ldb : K;
    unsigned voffA[2], voffB[2];
#pragma unroll
    for (int i = 0; i < 2; ++i) { int R, C; stage_rc(tid * 16 + i * 8192, R, C); const int Rb = Epi::PERM ? ((R & ~31) + perm32(R & 31)) : R;
        voffA[i] = (unsigned)(R * lda + C) * 2u; voffB[i] = (unsigned)(Rb * ldb + C) * 2u; }
    const size_t kstep = (size_t)(BK * 2);
    const size_t hstepA = (size_t)HALF * lda * 2, hstepB = (size_t)HALF * ldb * 2;
    const size_t tstepA = 2 * hstepA, tstepB = 2 * hstepB;
    const unsigned ldsw = (unsigned)wid * 1024u;
    const int aoff = F8 ? lds_byte(wr * 64 + fr, (fq >> 1) * 32 + (fq & 1) * 16) : lds_byte(wr * 64 + fr, fq * 8), boff = F8 ? lds_byte(wc * 32 + fr, (fq >> 1) * 32 + (fq & 1) * 16) : lds_byte(wc * 32 + fr, fq * 8);
    const int aoff1 = F8 ? lds_byte(wr * 64 + fr, (fq >> 1) * 32 + (fq & 1) * 16 + 8) - aoff : 1024, boff1 = F8 ? lds_byte(wc * 32 + fr, (fq >> 1) * 32 + (fq & 1) * 16 + 8) - boff : 1024;
#define PG8_SA(b, h) (((b) * 2 + (h)) * HTB)
#define PG8_SB(b, h) ((4 + (b) * 2 + (h)) * HTB)
#define PG8_STAGE(bufoff, gbase, voff) do { _Pragma("unroll") for (int _i = 0; _i < 2; ++_i) \
        __builtin_amdgcn_global_load_lds((const unsigned*)((const char*)(gbase) + (voff)[_i]), (PG8_LAS unsigned*)(lds + (bufoff) + ldsw + _i * 8192), 16, 0, 0); } while (0)
#define PG8_LDA(dst, b, h) do { if constexpr (F8) { _Pragma("unroll") for (int m = 0; m < 4; ++m) dst##8[m] = __builtin_shufflevector(*(const PG8_LAS i32x4_*)(lds + PG8_SA(b, h) + aoff + m * 2048), *(const PG8_LAS i32x4_*)(lds + PG8_SA(b, h) + aoff + m * 2048 + aoff1), 0, 1, 2, 3, 4, 5, 6, 7); } \
        else { _Pragma("unroll") for (int m = 0; m < 4; ++m) _Pragma("unroll") for (int k = 0; k < 2; ++k) dst[m][k] = *(const PG8_LAS bf16x8*)(lds + PG8_SA(b, h) + aoff + m * 2048 + k * 1024); } } while (0)
#define PG8_LDB(dst, b, h) do { if constexpr (F8) { _Pragma("unroll") for (int n = 0; n < 2; ++n) dst##8[n] = __builtin_shufflevector(*(const PG8_LAS i32x4_*)(lds + PG8_SB(b, h) + boff + n * 2048), *(const PG8_LAS i32x4_*)(lds + PG8_SB(b, h) + boff + n * 2048 + boff1), 0, 1, 2, 3, 4, 5, 6, 7); } \
        else { _Pragma("unroll") for (int n = 0; n < 2; ++n) _Pragma("unroll") for (int k = 0; k < 2; ++k) dst[n][k] = *(const PG8_LAS bf16x8*)(lds + PG8_SB(b, h) + boff + n * 2048 + k * 1024); } } while (0)
#define PG8_MMA(ai, bj, At, Bt) do { __builtin_amdgcn_s_setprio(1); \
        if constexpr (F8) { _Pragma("unroll") for (int m = 0; m < 4; ++m) _Pragma("unroll") for (int n = 0; n < 2; ++n) \
            asm volatile("v_mfma_scale_f32_16x16x128_f8f6f4 %0, %1, %2, %0, %3, %3 op_sel_hi:[0,0,0]" : "+v"(acc[ai][bj][m][n]) : "v"(Bt##8[n]), "v"(At##8[m]), "v"(f8_unit_scale)); } \
        else { _Pragma("unroll") for (int m = 0; m < 4; ++m) _Pragma("unroll") for (int n = 0; n < 2; ++n) _Pragma("unroll") for (int k = 0; k < 2; ++k) \
            acc[ai][bj][m][n] = __builtin_amdgcn_mfma_f32_16x16x32_bf16(Bt[n][k], At[m][k], acc[ai][bj][m][n], 0, 0, 0); } \
        __builtin_amdgcn_s_setprio(0); } while (0)
#define PG8_WAIT_V(n) asm volatile("s_waitcnt vmcnt(" #n ")" ::: "memory")
#define PG8_WAIT_L(n) asm volatile("s_waitcnt lgkmcnt(" #n ")" ::: "memory")
#define PG8_BAR __builtin_amdgcn_s_barrier()
#define PG8_SCHED __builtin_amdgcn_sched_barrier(0)
    Unit cur, nxt; int ui = 0;
    if (!S.next(0, cur)) return;
    f32x4 acc[2][2][4][2];
#pragma unroll
    for (int a = 0; a < 2; ++a)
#pragma unroll
        for (int b = 0; b < 2; ++b)
#pragma unroll
            for (int m = 0; m < 4; ++m)
#pragma unroll
                for (int n = 0; n < 2; ++n) acc[a][b][m][n] = (f32x4){0.f, 0.f, 0.f, 0.f};
    typedef int i32x4_ __attribute__((ext_vector_type(4))); typedef int i32x8_ __attribute__((ext_vector_type(8)));
    const int f8_unit_scale = 0x7F7F7F7F;
    bf16x8 At[4][2], B0[2][2], B1[2][2]; i32x8_ At8[4], B08[2], B18[2];
    const char* cA = (const char*)g.A + (size_t)cur.pm * tstepA + (size_t)cur.aoff * 2; const char* cB = (const char*)g.Bt + (size_t)cur.pn * tstepB + (size_t)cur.boff * 2;
    S.a_ready(cur);
    if constexpr (SP2) {
        PG8_STAGE(PG8_SB(0, 0), cB, voffB); PG8_STAGE(PG8_SB(0, 1), cB + hstepB, voffB); PG8_STAGE(PG8_SA(0, 0), cA, voffA); PG8_STAGE(PG8_SA(0, 1), cA + hstepA, voffA);
        if (wr == 1) PG8_BAR;
        PG8_WAIT_V(2); PG8_BAR;
        PG8_STAGE(PG8_SB(1, 0), cB + kstep, voffB); PG8_STAGE(PG8_SA(1, 0), cA + kstep, voffA); PG8_STAGE(PG8_SB(1, 1), cB + hstepB + kstep, voffB);
        PG8_WAIT_V(6); PG8_BAR;
    } else {
        PG8_STAGE(PG8_SB(0, 0), cB, voffB); PG8_STAGE(PG8_SA(0, 0), cA, voffA); PG8_STAGE(PG8_SB(0, 1), cB + hstepB, voffB); PG8_STAGE(PG8_SA(0, 1), cA + hstepA, voffA);
        if (wr == 1) PG8_BAR;
        PG8_WAIT_V(4); PG8_BAR;
        PG8_STAGE(PG8_SB(1, 0), cB + kstep, voffB); PG8_STAGE(PG8_SA(1, 0), cA + kstep, voffA); PG8_STAGE(PG8_SB(1, 1), cB + hstepB + kstep, voffB);
        PG8_WAIT_V(6); PG8_BAR;
    }
    for (;;) {
        const bool has_next = S.next(ui + 1, nxt);
        const char* nA = has_next ? (const char*)g.A + (size_t)nxt.pm * tstepA + (size_t)nxt.aoff * 2 : cA; const char* nB = has_next ? (const char*)g.Bt + (size_t)nxt.pn * tstepB + (size_t)nxt.boff * 2 : cB;
        for (int t = 0; t < nt; t += 2) {
            const bool last = (t == nt - 2);
            const char* a1 = cA + (size_t)(t + 1) * kstep;
            const char* a2 = last ? nA : cA + (size_t)(t + 2) * kstep; const char* b2 = last ? nB : cB + (size_t)(t + 2) * kstep;
            const char* a3 = a2 + kstep; const char* b3 = b2 + kstep;
            if (last && has_next) S.a_ready(nxt);
            if constexpr (SP2) {
            PG8_LDB(B0, 0, 0); PG8_LDB(B1, 0, 1); PG8_SCHED; PG8_LDA(At, 0, 0); PG8_STAGE(PG8_SA(1, 1), a1 + hstepA, voffA);
            PG8_WAIT_V(8); PG8_WAIT_L(0); PG8_BAR; PG8_MMA(0, 0, At, B0); PG8_MMA(0, 1, At, B1); PG8_BAR; PG8_SCHED;
            PG8_LDA(At, 0, 1); PG8_STAGE(PG8_SB(0, 0), b2, voffB); PG8_STAGE(PG8_SB(0, 1), b2 + hstepB, voffB); PG8_STAGE(PG8_SA(0, 0), a2, voffA);
            PG8_WAIT_V(8); PG8_WAIT_L(0); PG8_BAR; PG8_MMA(1, 0, At, B0); PG8_MMA(1, 1, At, B1); PG8_BAR; PG8_SCHED;
            PG8_LDB(B0, 1, 0); PG8_LDB(B1, 1, 1); PG8_SCHED; PG8_LDA(At, 1, 0); PG8_STAGE(PG8_SA(0, 1), a2 + hstepA, voffA);
            PG8_WAIT_V(8); PG8_WAIT_L(0); PG8_BAR; PG8_MMA(0, 0, At, B0); PG8_MMA(0, 1, At, B1); PG8_BAR; PG8_SCHED;
            PG8_LDA(At, 1, 1); PG8_STAGE(PG8_SB(1, 0), b3, voffB); PG8_STAGE(PG8_SB(1, 1), b3 + hstepB, voffB); PG8_STAGE(PG8_SA(1, 0), a3, voffA);
            PG8_WAIT_V(8); PG8_WAIT_L(0); PG8_BAR; PG8_MMA(1, 0, At, B0); PG8_MMA(1, 1, At, B1); PG8_BAR; PG8_SCHED;
            } else {
            PG8_LDB(B0, 0, 0); PG8_SCHED; PG8_LDA(At, 0, 0); PG8_STAGE(PG8_SA(1, 1), a1 + hstepA, voffA);
            PG8_WAIT_L(8); PG8_BAR; PG8_WAIT_L(0); PG8_MMA(0, 0, At, B0); PG8_BAR; PG8_SCHED;
            PG8_LDB(B1, 0, 1); PG8_STAGE(PG8_SB(0, 0), b2, voffB);
            PG8_BAR; PG8_WAIT_L(0); PG8_MMA(0, 1, At, B1); PG8_BAR;
            PG8_LDA(At, 0, 1); PG8_STAGE(PG8_SA(0, 0), a2, voffA);
            PG8_BAR; PG8_WAIT_L(0); PG8_MMA(1, 0, At, B0); PG8_BAR; PG8_SCHED;
            PG8_STAGE(PG8_SB(0, 1), b2 + hstepB, voffB);
            PG8_WAIT_V(6); PG8_BAR; PG8_MMA(1, 1, At, B1); PG8_BAR;
            PG8_LDB(B0, 1, 0); PG8_SCHED; PG8_LDA(At, 1, 0); PG8_STAGE(PG8_SA(0, 1), a2 + hstepA, voffA);
            PG8_WAIT_L(8); PG8_BAR; PG8_WAIT_L(0); PG8_MMA(0, 0, At, B0); PG8_BAR; PG8_SCHED;
            PG8_LDB(B1, 1, 1); PG8_STAGE(PG8_SB(1, 0), b3, voffB);
            PG8_BAR; PG8_WAIT_L(0); PG8_MMA(0, 1, At, B1); PG8_BAR;
            PG8_LDA(At, 1, 1); PG8_STAGE(PG8_SA(1, 0), a3, voffA);
            PG8_BAR; PG8_WAIT_L(0); PG8_MMA(1, 0, At, B0); PG8_BAR; PG8_SCHED;
            PG8_STAGE(PG8_SB(1, 1), b3 + hstepB, voffB);
            PG8_WAIT_V(6); PG8_BAR; PG8_MMA(1, 1, At, B1); PG8_BAR;
            }
        }
        if constexpr (F8) asm volatile("s_nop 15\n\ts_nop 15\n\ts_nop 15\n\ts_nop 15" ::: "memory");
        if constexpr (ALIGN_EPI) { if (wr == 0) PG8_BAR; }
        if constexpr (!Epi::AFTER_DRAIN) { E(acc, cur, wr, wc, fr, fq); S.done(cur); }
        if (!has_next) break;
        if (!(EpiChain<Epi>::value && cur.aux == 0)) {
#pragma unroll
        for (int a = 0; a < 2; ++a)
#pragma unroll
            for (int b = 0; b < 2; ++b)
#pragma unroll
                for (int m = 0; m < 4; ++m)
#pragma unroll
                    for (int n = 0; n < 2; ++n) acc[a][b][m][n] = (f32x4){0.f, 0.f, 0.f, 0.f};
        }
        cur = nxt; cA = nA; cB = nB; ++ui;
        if constexpr (ALIGN_EPI) { if (wr == 1) PG8_BAR; }
    }
    PG8_WAIT_V(0);
    if constexpr (!ALIGN_EPI) { if (wr == 0) PG8_BAR; }
    PG8_BAR;
    if constexpr (Epi::AFTER_DRAIN) { E.fused(acc, cur, wr, wc, fr, fq, lds, wid, lane); S.done(cur); }
#undef PG8_SA
#undef PG8_SB
#undef PG8_STAGE
#undef PG8_LDA
#undef PG8_LDB
#undef PG8_MMA
#undef PG8_WAIT_V
#undef PG8_WAIT_L
#undef PG8_BAR
#undef PG8_SCHED
}
}
#define GAS __attribute__((address_space(1)))
#define LAS __attribute__((address_space(3)))
typedef unsigned short bf16;
typedef unsigned v4u __attribute__((ext_vector_type(4)));
typedef float f32x4 __attribute__((ext_vector_type(4)));
typedef short bf16x8 __attribute__((ext_vector_type(8)));
typedef GAS unsigned gu32;
typedef GAS unsigned long long gu64;
#define RLX_AGENT __ATOMIC_RELAXED, __HIP_MEMORY_SCOPE_AGENT
#define LDS_WAIT() asm volatile("s_waitcnt lgkmcnt(0)" ::: "memory")
#define VM_WAIT() asm volatile("s_waitcnt vmcnt(0)" ::: "memory")
__device__ __forceinline__ unsigned long long rt() { return __builtin_amdgcn_s_memrealtime(); }
__device__ __forceinline__ unsigned f2bf(float f) { unsigned u = __builtin_bit_cast(unsigned, f); return (u + 0x7fffu + ((u >> 16) & 1u)) >> 16; }
__device__ __forceinline__ unsigned pk2(float lo, float hi) { return f2bf(lo) | (f2bf(hi) << 16); }

#define XB_TMO      128
#define XB_XCNT(j)  (256  + 64 * (j))
#define XB_XSUB(j)  (1280 + 64 * (j))
#define XB_XGEN(j)  (2304 + 64 * (j))
#define XB_TOP      3328
#define XB_TOPGEN   3392
#define XCD_BAR_WORDS 3456
#define XB_SPIN_CAP (1u << 18)

__device__ __forceinline__ unsigned xb_ld(unsigned* p)              { return __hip_atomic_load(p, __ATOMIC_RELAXED, __HIP_MEMORY_SCOPE_AGENT); }
__device__ __forceinline__ unsigned xb_add(unsigned* p, unsigned v) { return __hip_atomic_fetch_add(p, v, __ATOMIC_RELAXED, __HIP_MEMORY_SCOPE_AGENT); }
__device__ __forceinline__ unsigned xb_xcc_id() { return (unsigned)__builtin_amdgcn_s_getreg((3 << 11) | 20) & 0xFu; }
#define XB_SPIN(cond, bar) do { unsigned _sp = 0; while (cond) { __builtin_amdgcn_s_sleep(1); \
    if ((++_sp & 255u) == 0u) { if (xb_ld(&(bar)[XB_TMO])) break; if (_sp > XB_SPIN_CAP) { atomicAdd(&(bar)[XB_TMO], 1u); break; } } } } while (0)

struct XcdBarrier {
    unsigned* bar; unsigned x;
    volatile LAS unsigned* st;
};

__device__ __forceinline__ XcdBarrier xcd_barrier_post(unsigned* bar, volatile LAS unsigned* st) {
    XcdBarrier b; b.bar = bar; b.x = xb_xcc_id(); b.st = st;
    if (threadIdx.x == 0) (void)xb_add(&bar[XB_XCNT(b.x)], 1u);
    return b;
}
__device__ __forceinline__ void xcd_barrier_complete(unsigned* bar, unsigned x, unsigned& nloc, unsigned& nx) {
    const unsigned G = gridDim.x * gridDim.y * gridDim.z;
    unsigned sum, cnt, mine, sp = 0u;
    for (;;) {
        sum = 0u; cnt = 0u; mine = 0u;
#pragma unroll
        for (unsigned j = 0; j < 16; ++j) { const unsigned c = xb_ld(&bar[XB_XCNT(j)]); sum += c; cnt += (c > 0u) ? 1u : 0u; mine = (j == x) ? c : mine; }
        if (sum == G) break;
        __builtin_amdgcn_s_sleep(1);
        if ((++sp & 255u) == 0u) { if (xb_ld(&bar[XB_TMO])) break; if (sp > XB_SPIN_CAP) { atomicAdd(&bar[XB_TMO], 1u); break; } }
    }
    nloc = mine > 0u ? mine : 1u; nx = cnt > 0u ? cnt : 1u;
}

__device__ __forceinline__ void xcd_barrier(const XcdBarrier& b) {
    asm volatile("s_waitcnt vmcnt(0)" ::: "memory");
    __syncthreads();
    if (threadIdx.x == 0) {
        unsigned* bar = b.bar;
        __builtin_amdgcn_s_waitcnt(0);
        unsigned nloc = b.st[0], nx = b.st[1];
        if (nloc == 0u) { xcd_barrier_complete(bar, b.x, nloc, nx); b.st[0] = nloc; b.st[1] = nx; }
        const unsigned old = xb_add(&bar[XB_XSUB(b.x)], 1u);
        const unsigned gen = old / nloc;
        if (old + 1u == (gen + 1u) * nloc) {
            __builtin_amdgcn_fence(__ATOMIC_RELEASE, "agent");
            asm volatile("s_waitcnt vmcnt(0)" ::: "memory");
            const unsigned og = xb_add(&bar[XB_TOP], 1u);
            const unsigned tg = og / nx;
            if (og + 1u == (tg + 1u) * nx) xb_add(&bar[XB_TOPGEN], 1u);
            else XB_SPIN(xb_ld(&bar[XB_TOPGEN]) == tg, bar);
            __builtin_amdgcn_fence(__ATOMIC_ACQUIRE, "agent");
            xb_add(&bar[XB_XGEN(b.x)], 1u);
            asm volatile("s_waitcnt vmcnt(0)" ::: "memory");
        } else {
            XB_SPIN(xb_ld(&bar[XB_XGEN(b.x)]) == gen, bar);
            __builtin_amdgcn_fence(__ATOMIC_ACQUIRE, "agent");
            asm volatile("s_waitcnt vmcnt(0)" ::: "memory");
        }
    }
    __syncthreads();
}
__device__ __forceinline__ float wave_sum(float v) {
#pragma unroll
    for (int o = 1; o < 64; o <<= 1) v += __shfl_xor(v, o);
    return v;
}
__device__ __forceinline__ void p0_transpose_item(const float* W, int K, int N, bf16* WT, int row_off, LAS float* scr, int item, int lane, int ldw = 0, unsigned char* W8 = nullptr, int n8_lo = 0, int n8_hi = 0, float s8 = 1.f) {
    if (ldw == 0) ldw = K;
    const int nblk = N / 32, kb = item / nblk, nb = item % nblk, k0 = 64 * kb, n0 = 32 * nb;
    float tv[32];
#pragma unroll
    for (int i = 0; i < 32; ++i) tv[i] = __builtin_nontemporal_load(W + (size_t)(k0 + 2 * i + (lane >> 5)) * N + n0 + (lane & 31));
#pragma unroll
    for (int i = 0; i < 32; ++i) scr[(2 * i + (lane >> 5)) * 33 + (lane & 31)] = tv[i];
    LDS_WAIT(); asm volatile("" ::: "memory");
    const int c = lane & 7;
#pragma unroll
    for (int j = 0; j < 4; ++j) { const int n = (lane >> 3) + 8 * j; const LAS float* s = scr + (8 * c) * 33 + n;
        if (W8 && n0 >= n8_lo && n0 < n8_hi) { int a = 0, b = 0;
            a = __builtin_amdgcn_cvt_pk_fp8_f32(s[0 * 33] * s8, s[1 * 33] * s8, a, false); a = __builtin_amdgcn_cvt_pk_fp8_f32(s[2 * 33] * s8, s[3 * 33] * s8, a, true);
            b = __builtin_amdgcn_cvt_pk_fp8_f32(s[4 * 33] * s8, s[5 * 33] * s8, b, false); b = __builtin_amdgcn_cvt_pk_fp8_f32(s[6 * 33] * s8, s[7 * 33] * s8, b, true);
            typedef unsigned u32x2h __attribute__((ext_vector_type(2))); *(GAS u32x2h*)(W8 + (size_t)(n0 - n8_lo + n) * K + k0 + 8 * c) = (u32x2h){(unsigned)a, (unsigned)b}; }
        else { v4u o; o.x = pk2(s[0 * 33], s[1 * 33]); o.y = pk2(s[2 * 33], s[3 * 33]); o.z = pk2(s[4 * 33], s[5 * 33]); o.w = pk2(s[6 * 33], s[7 * 33]);
            *(GAS v4u*)(WT + (size_t)(row_off + n0 + n) * ldw + k0 + 8 * c) = o; } }
    LDS_WAIT(); asm volatile("" ::: "memory");
}

constexpr int NWAVES = 8;
#ifndef MK_N_LAUNCHES
#define MK_N_LAUNCHES 1
#endif
constexpr int NPH = 13;
constexpr int N_LAUNCHES = MK_N_LAUNCHES;
static_assert(N_LAUNCHES == 1 || N_LAUNCHES == NPH, "MK_N_LAUNCHES is 1 or NPH");

constexpr int TOK = 8192, DM = 2048, SEQ = 4096, NIN = 9216, MEMT = 512;
constexpr float EPS = 1e-6f;
constexpr size_t MiB = 1u << 20;
constexpr size_t WS_CTL = 0, CTL_ZERO_BYTES = 1 * MiB;
constexpr size_t WS_SUBK = 1 * MiB;
constexpr size_t WS_PS1 = 2 * MiB, WS_PS2 = 3 * MiB;
constexpr size_t WS_WIN = 4 * MiB;
constexpr size_t WS_WUPA = 40 * MiB, WS_WUPB = 44 * MiB;
constexpr size_t WS_WOUT = 48 * MiB, WS_WMQ = 56 * MiB, WS_WMKV = 64 * MiB, WS_WMO = 80 * MiB, WS_WPQ = 88 * MiB;
constexpr size_t WS_PU = 96 * MiB, WS_PV = 160 * MiB;
constexpr size_t WS_S0 = 224 * MiB;
constexpr size_t WS_S1 = 256 * MiB;
constexpr size_t WS_S2 = 288 * MiB;
constexpr size_t WS_S3 = 320 * MiB;
constexpr size_t WS_S4 = 352 * MiB;
constexpr size_t WS_S6 = 416 * MiB;
constexpr size_t WS_KM = 480 * MiB, WS_MN = 484 * MiB, WS_END = 486 * MiB;
constexpr size_t WS_A0F8 = 432 * MiB, WS_WIN8 = 448 * MiB;
constexpr size_t WS_WMKV8 = 464 * MiB, WS_MN8 = 472 * MiB;
constexpr size_t WS_WKT = 176 * MiB, WS_VWOT = 184 * MiB;
constexpr int CW_TMO = 0, CW_CODE = 1, CW_BAR = 4096;

constexpr int TAB1 = 9216;
constexpr int RING_OFF = 0, RING_BYTES = 131072;
constexpr int LDSCTL_OFF = RING_BYTES, MISC_OFF = LDSCTL_OFF + 320;
constexpr int LDS_BYTES = 147456;

typedef float f32x2g __attribute__((ext_vector_type(2)));
typedef unsigned u32x2 __attribute__((ext_vector_type(2)));
#define DI __device__ __forceinline__
#define MFMA16(a, b, c) __builtin_amdgcn_mfma_f32_16x16x32_bf16((a), (b), (c), 0, 0, 0)

struct Frame {
    LAS unsigned char* lds;
    volatile LAS unsigned* MISC;
    gu32* ctl;
    int tid, lane, wave, vcu, G;
    const float* in[23];
    float* out; unsigned char* ws;
};
enum { I_X = 0, I_MEM, I_GMIX, I_WIN, I_LNG, I_LNB, I_WS, I_BS, I_RELB, I_WUPA, I_WUPB, I_WOUT, I_GMQ, I_GMKV, I_MWQ, I_MWKV, I_MWO, I_GFFN, I_PWQ, I_SUBK, I_PU, I_PV, I_GFIN };

DI float wave_max(float v) {
#pragma unroll
    for (int o = 1; o < 64; o <<= 1) v = fmaxf(v, __shfl_xor(v, o));
    return v;
}
DI float gelu1(float v) {
    const float av = fabsf(v), t = __builtin_amdgcn_rcpf(av * 0.2316418882f + 1.0f);
    float q = t * 0.5307027145f + (-0.7265760135f); q = q * t + 0.7107068705f; q = q * t + (-0.142248368f); q = q * t + 0.127414796f; q = q * t;
    const float e = __builtin_amdgcn_exp2f((v * v) * (-0.72134752044f)); const float m = v * (q * e);
    return v < 0.f ? m : v - m;
}
DI float bflo(unsigned w) { return __builtin_bit_cast(float, w << 16); }
DI float bfhi(unsigned w) { return __builtin_bit_cast(float, w & 0xffff0000u); }

DI void rms_row_to_bf16(int lane, const float* xrow, const float* gain, bf16* orow, unsigned char* o8row = nullptr, float s8 = 1.f) {
    const GAS f32x4* xr = (const GAS f32x4*)xrow + lane; const GAS f32x4* gr = (const GAS f32x4*)gain + lane;
    f32x4 v[8]; float s = 0.f;
#pragma unroll
    for (int j = 0; j < 8; ++j) { v[j] = __builtin_nontemporal_load(xr + 64 * j); s += (v[j].x * v[j].x + v[j].y * v[j].y) + (v[j].z * v[j].z + v[j].w * v[j].w); }
    const float rstd = 1.0f / sqrtf(wave_sum(s) * (1.f / DM) + EPS);
    GAS unsigned long long* o8 = (GAS unsigned long long*)orow + lane;
#pragma unroll
    for (int j = 0; j < 8; ++j) { const f32x4 g = gr[64 * j];
        o8[64 * j] = (unsigned long long)pk2(v[j].x * rstd * g.x, v[j].y * rstd * g.y) | ((unsigned long long)pk2(v[j].z * rstd * g.z, v[j].w * rstd * g.w) << 32);
        if (o8row) { int a = 0; const float r8 = rstd * s8; a = __builtin_amdgcn_cvt_pk_fp8_f32(v[j].x * r8 * g.x, v[j].y * r8 * g.y, a, false); a = __builtin_amdgcn_cvt_pk_fp8_f32(v[j].z * r8 * g.z, v[j].w * r8 * g.w, a, true);
            *((GAS unsigned*)o8row + lane + 64 * j) = (unsigned)a; } }
}
DI void peer_tables(Frame& F, int gw, int NGW, int r_lo, int r_hi) {
    unsigned char* ws = F.ws;
    {
            unsigned char* PU4 = ws + WS_PU; float* FS = (float*)(ws + WS_PU + 64 * MiB);
            for (int r0 = r_lo + gw; r0 < r_hi; r0 += 2 * NGW) {
                const int rr[2] = {r0, r0 + NGW < r_hi ? r0 + NGW : r0};
                f32x4 v[2][8]; float am[2] = {0.f, 0.f};
#pragma unroll
                for (int k = 0; k < 2; ++k) { const int r = rr[k]; const bool second = r >= 16384; const float* src = (second ? F.in[I_PV] : F.in[I_PU]) + (size_t)(second ? r - 16384 : r) * DM + 4 * F.lane;
#pragma unroll
                    for (int i = 0; i < 8; ++i) v[k][i] = __builtin_nontemporal_load((const GAS f32x4*)(src + 256 * i)); }
#pragma unroll
                for (int k = 0; k < 2; ++k) { const int r = rr[k];
#pragma unroll
                    for (int i = 0; i < 8; ++i) am[k] = fmaxf(am[k], fmaxf(fmaxf(fabsf(v[k][i].x), fabsf(v[k][i].y)), fmaxf(fabsf(v[k][i].z), fabsf(v[k][i].w))));
                    am[k] = wave_max(am[k]); const float inv = am[k] > 0.f ? 6.0f / am[k] : 0.f;
                    unsigned w[4];
#pragma unroll
                    for (int c = 0; c < 4; ++c) { unsigned x = 0u;
                        x = __builtin_amdgcn_cvt_scalef32_pk_fp4_f32(x, v[k][2 * c].x * inv, v[k][2 * c].y * inv, 1.0f, 0); x = __builtin_amdgcn_cvt_scalef32_pk_fp4_f32(x, v[k][2 * c].z * inv, v[k][2 * c].w * inv, 1.0f, 1);
                        x = __builtin_amdgcn_cvt_scalef32_pk_fp4_f32(x, v[k][2 * c + 1].x * inv, v[k][2 * c + 1].y * inv, 1.0f, 2); x = __builtin_amdgcn_cvt_scalef32_pk_fp4_f32(x, v[k][2 * c + 1].z * inv, v[k][2 * c + 1].w * inv, 1.0f, 3);
                        w[c] = x; }
                    *((GAS v4u*)(PU4 + (size_t)r * 1024) + F.lane) = (v4u){w[0], w[1], w[2], w[3]};
                    if (F.lane == 0) FS[r] = am[k] * (1.0f / 6.0f); }
            }
        }
}
DI void p0_prologue(Frame& F) {
    LAS float* scr = (LAS float*)(F.lds + RING_OFF + F.wave * 16384);
    const int gw = F.vcu * NWAVES + F.wave, NGW = F.G * NWAVES;
    unsigned char* ws = F.ws;
    constexpr int I_IN = (DM / 64) * (NIN / 32), I_UP = (1024 / 64) * (DM / 32), I_SQ = (DM / 64) * (DM / 32), I_KV = (DM / 64) * (4096 / 32);
    constexpr int NITEMS = I_IN + 2 * I_UP + 2 * I_SQ + I_KV;
#ifndef DBG_P0DUP
#define DBG_P0DUP 0
#endif
    for (int dup = 0; dup < ((DBG_P0DUP & 1) ? 2 : 1); ++dup)
    for (int it = gw; it < NITEMS; it += NGW) {
        int r = it;
        if (r < I_IN) { p0_transpose_item(F.in[I_WIN], DM, NIN, (bf16*)(ws + WS_WIN), 0, scr, r, F.lane, 0, ws + WS_WIN8, 2048, NIN, 256.0f); continue; } r -= I_IN;
        if (r < I_UP) { p0_transpose_item(F.in[I_WUPA], 1024, DM, (bf16*)(ws + WS_WUPA), 0, scr, r, F.lane, 0, ws + WS_WUPA, 0, DM, 256.0f); continue; } r -= I_UP;
        if (r < I_UP) { p0_transpose_item(F.in[I_WUPB], 1024, DM, (bf16*)(ws + WS_WUPB), 0, scr, r, F.lane, 0, ws + WS_WUPB, 0, DM, 256.0f); continue; } r -= I_UP;
        if (r < I_SQ) { p0_transpose_item(F.in[I_WOUT], DM, DM, (bf16*)(ws + WS_WOUT), 0, scr, r, F.lane, 0, ws + WS_WOUT, 0, DM, 256.0f); continue; } r -= I_SQ;
        if (r < I_SQ) { p0_transpose_item(F.in[I_MWO], DM, DM, (bf16*)(ws + WS_WMO), 0, scr, r, F.lane); continue; } r -= I_SQ;
        p0_transpose_item(F.in[I_MWKV], DM, 4096, (bf16*)(ws + WS_WMKV), 0, scr, r, F.lane, 0, ws + WS_WMKV8, 0, 4096, 256.0f);
    }
    for (int it = gw; it < 16 * 32 * 4; it += NGW) {
        const int hp = it >> 7, kb = ((it >> 2) & 31) * 64, mq = it & 3, pp = hp & 1, fr = F.lane & 15, fq = F.lane >> 4;
        const float* Ag = F.in[I_SUBK] + (size_t)pp * 128 * 128 + (size_t)(32 * mq + fr) * 128 + 8 * fq; const float* Bg = F.in[I_PWQ] + (size_t)(kb + fr) * DM + hp * 128 + 8 * fq;
        f32x4 bl[4][4][2], al[4][2][2];
#pragma unroll
        for (int ks = 0; ks < 4; ++ks) {
#pragma unroll
            for (int n = 0; n < 4; ++n) { const float* p = Bg + (size_t)(16 * n) * DM + ks * 32; bl[ks][n][0] = *(const GAS f32x4*)p; bl[ks][n][1] = *(const GAS f32x4*)(p + 4); }
#pragma unroll
            for (int m = 0; m < 2; ++m) { const float* p = Ag + (size_t)(16 * m) * 128 + ks * 32; al[ks][m][0] = *(const GAS f32x4*)p; al[ks][m][1] = *(const GAS f32x4*)(p + 4); }
        }
        f32x4 acc[2][4];
#pragma unroll
        for (int m = 0; m < 2; ++m)
#pragma unroll
            for (int n = 0; n < 4; ++n) acc[m][n] = (f32x4){0.f, 0.f, 0.f, 0.f};
#pragma unroll
        for (int ks = 0; ks < 4; ++ks) {
            bf16x8 bfr[4];
#pragma unroll
            for (int n = 0; n < 4; ++n) { const f32x4 a = bl[ks][n][0], b = bl[ks][n][1]; const v4u w = (v4u){pk2(a.x, a.y), pk2(a.z, a.w), pk2(b.x, b.y), pk2(b.z, b.w)}; bfr[n] = __builtin_bit_cast(bf16x8, w); }
#pragma unroll
            for (int m = 0; m < 2; ++m) { const f32x4 a = al[ks][m][0], b = al[ks][m][1]; const v4u w = (v4u){pk2(a.x, a.y), pk2(a.z, a.w), pk2(b.x, b.y), pk2(b.z, b.w)}; const bf16x8 afr = __builtin_bit_cast(bf16x8, w);
#pragma unroll
                for (int n = 0; n < 4; ++n) acc[m][n] = __builtin_amdgcn_mfma_f32_16x16x32_bf16(bfr[n], afr, acc[m][n], 0, 0, 0); }
        }
        bf16* WF = (bf16*)(ws + WS_WPQ);
#pragma unroll
        for (int m = 0; m < 2; ++m)
#pragma unroll
            for (int n = 0; n < 4; ++n) { typedef unsigned u32x2l __attribute__((ext_vector_type(2))); u32x2l o; o.x = pk2(acc[m][n][0], acc[m][n][1]); o.y = pk2(acc[m][n][2], acc[m][n][3]);
                *(GAS u32x2l*)(WF + (size_t)(hp * 128 + 32 * mq + 16 * m + fr) * DM + kb + 16 * n + 4 * fq) = o; }
    }
    {
        const size_t gt = (size_t)(F.vcu * NWAVES + F.wave) * 64 + F.lane, NT = (size_t)F.G * NWAVES * 64;
        for (size_t i = gt; i < (size_t)DM * DM / 8; i += NT) {
            const GAS f32x4* s = (const GAS f32x4*)F.in[I_MWQ] + 2 * i; const f32x4 a = __builtin_nontemporal_load(s), b = __builtin_nontemporal_load(s + 1);
            v4u o; o.x = pk2(a.x, a.y); o.y = pk2(a.z, a.w); o.z = pk2(b.x, b.y); o.w = pk2(b.z, b.w);
            *((GAS v4u*)(ws + WS_WMQ) + i) = o;
        }
    }
    for (int dup = 0; dup < ((DBG_P0DUP & 4) ? 2 : 1); ++dup)
    for (int m = gw; m < TOK; m += NGW) rms_row_to_bf16(F.lane, F.in[I_X] + (size_t)m * DM, F.in[I_GMIX], (bf16*)(ws + WS_S0) + (size_t)m * DM, ws + WS_A0F8 + (size_t)m * DM, 16.0f);
    for (int m = gw; m < MEMT; m += NGW) rms_row_to_bf16(F.lane, F.in[I_MEM] + (size_t)m * DM, F.in[I_GMKV], (bf16*)(ws + WS_MN) + (size_t)m * DM, ws + WS_MN8 + (size_t)m * DM, 16.0f);
}

DI void sg_unit(Frame& F, int unit) {
    const int blk = unit >> 2, g = unit & 3, tid = F.tid, lane = F.lane, w = F.wave, fr = lane & 15, fq = lane >> 4;
    LAS float* RED = (LAS float*)(F.lds);
    LAS float* ST = (LAS float*)(F.lds + 8192);
    LAS float* R01 = (LAS float*)(F.lds + 9216);
    LAS bf16* WP = (LAS bf16*)(F.lds + 10240);
    const bf16* ZVT = (const bf16*)(F.ws + WS_S1 + 16 * MiB) + (size_t)blk * 1024 * 128;
    const int wr = w >> 2, wc = w & 3;
    const float* Wg = F.in[I_WS] + (size_t)g * 128 * 128;
    f32x4 wa[4], wb[4];
#pragma unroll
    for (int k = 0; k < 4; ++k) { const int id = tid + 512 * k, i = id >> 4, j0 = (id & 15) * 8; wa[k] = *(const GAS f32x4*)(Wg + i * 128 + j0); wb[k] = *(const GAS f32x4*)(Wg + i * 128 + j0 + 4); }
    const bf16* Bg = ZVT + (size_t)(g * 256 + wc * 64 + fr) * 128 + 8 * fq;
    bf16x8 bfr[4][4];
#pragma unroll
    for (int ks = 0; ks < 4; ++ks)
#pragma unroll
        for (int n = 0; n < 4; ++n) bfr[ks][n] = *(const GAS bf16x8*)(Bg + (size_t)(16 * n) * 128 + ks * 32);
    __syncthreads();
    if (tid < 128) {
        const GAS f32x4* ps = (const GAS f32x4*)((const float*)(F.ws + WS_SUBK) + (size_t)(blk * 128 + tid) * 32); float s = 0.f, q = 0.f;
#pragma unroll
        for (int k = 0; k < 8; ++k) { const f32x4 t = ps[k]; s += t.x + t.z; q += t.y + t.w; }
        const float mean = s * (1.f / 1024.f); float var = q * (1.f / 1024.f) - mean * mean; var = var < 0.f ? 0.f : var;
        ST[tid * 2] = mean; ST[tid * 2 + 1] = 1.0f / sqrtf(var + EPS); }
    __syncthreads();
    {
#pragma unroll
        for (int k = 0; k < 4; ++k) { const int id = tid + 512 * k, i = id >> 4, j0 = (id & 15) * 8;
            const f32x4 a = wa[k], b = wb[k];
            const float mk = ((i >> 6) >= (j0 >> 6)) ? 1.f : 0.f;
            float v[8] = {a.x, a.y, a.z, a.w, b.x, b.y, b.z, b.w}; unsigned o[4]; float r0 = 0.f, r1 = 0.f;
#pragma unroll
            for (int e = 0; e < 4; ++e) { o[e] = pk2(v[2 * e] * mk * ST[(j0 + 2 * e) * 2 + 1], v[2 * e + 1] * mk * ST[(j0 + 2 * e + 1) * 2 + 1]);
                r0 += (v[2 * e] + v[2 * e + 1]) * mk; r1 += bflo(o[e]) * ST[(j0 + 2 * e) * 2] + bfhi(o[e]) * ST[(j0 + 2 * e + 1) * 2]; }
            *(LAS v4u*)(WP + i * 136 + j0) = (v4u){o[0], o[1], o[2], o[3]};
#pragma unroll
            for (int sft = 1; sft < 16; sft <<= 1) { r0 += __shfl_xor(r0, sft); r1 += __shfl_xor(r1, sft); }
            if ((id & 15) == 0) { R01[i * 2] = r0; R01[i * 2 + 1] = r1; } }
    }
    __syncthreads();
    f32x4 acc[4][4];
#pragma unroll
    for (int m = 0; m < 4; ++m)
#pragma unroll
        for (int n = 0; n < 4; ++n) acc[m][n] = (f32x4){0.f, 0.f, 0.f, 0.f};
    const bf16* ZU = (const bf16*)(F.ws + WS_S1);
    u32x2 zuw[4][4];
#pragma unroll
    for (int m = 0; m < 4; ++m)
#pragma unroll
        for (int n = 0; n < 4; ++n) zuw[m][n] = *(const GAS u32x2*)(ZU + (size_t)(blk * 128 + wr * 64 + 16 * m + fr) * 1024 + g * 256 + wc * 64 + 16 * n + 4 * fq);
#pragma unroll
    for (int ks = 0; ks < 4; ++ks) {
        bf16x8 afrag[4];
#pragma unroll
        for (int m = 0; m < 4; ++m) afrag[m] = *(const LAS bf16x8*)(WP + (wr * 64 + 16 * m + fr) * 136 + ks * 32 + 8 * fq);
#pragma unroll
        for (int m = 0; m < 4; ++m)
#pragma unroll
            for (int n = 0; n < 4; ++n) acc[m][n] = MFMA16(bfr[ks][n], afrag[m], acc[m][n]);
    }
    bf16* YA = (bf16*)(F.ws + WS_S3);
#pragma unroll
    for (int m = 0; m < 4; ++m) { const int i = wr * 64 + 16 * m + fr; const float r0 = R01[i * 2], r1 = R01[i * 2 + 1], bs = F.in[I_BS][g * 128 + i]; const size_t trow = (size_t)(blk * 128 + i) * 1024;
#pragma unroll
        for (int n = 0; n < 4; ++n) { const int ch = g * 256 + wc * 64 + 16 * n + 4 * fq;
            const f32x4 lg = *(const GAS f32x4*)(F.in[I_LNG] + ch), lb = *(const GAS f32x4*)(F.in[I_LNB] + ch);
            const u32x2 zu = zuw[m][n];
            const float s0 = lg.x * (acc[m][n][0] - r1) + lb.x * r0 + bs, s1 = lg.y * (acc[m][n][1] - r1) + lb.y * r0 + bs, s2 = lg.z * (acc[m][n][2] - r1) + lb.z * r0 + bs, s3 = lg.w * (acc[m][n][3] - r1) + lb.w * r0 + bs;
            int o8 = 0; o8 = __builtin_amdgcn_cvt_pk_fp8_f32(bflo(zu.x) * s0 * 8.0f, bfhi(zu.x) * s1 * 8.0f, o8, false); o8 = __builtin_amdgcn_cvt_pk_fp8_f32(bflo(zu.y) * s2 * 8.0f, bfhi(zu.y) * s3 * 8.0f, o8, true);
            *(GAS unsigned*)((unsigned char*)YA + trow + ch) = (unsigned)o8; } }
}

DI void attn_unit(Frame& F, int unit) {
    const int cp = unit & 31, h = (unit >> 5) & 7, b = unit >> 8, tid = F.tid, lane = F.lane, w = F.wave, fr = lane & 15, fq = lane >> 4;
    LAS bf16* QL = (LAS bf16*)(F.lds);
    LAS bf16* KL = QL + 128 * 136;
    LAS bf16* VL = KL + 64 * 136;
    LAS bf16* PL = VL + 128 * 72;
    LAS float* BL = (LAS float*)(PL + 8 * 16 * 72);
    const bf16* QK = (const bf16*)(F.ws + WS_S2); const bf16* VT = (const bf16*)(F.ws + WS_S6); bf16* YB = (bf16*)(F.ws + WS_S3 + 16 * MiB);
    const int t0 = cp * 128, cq = 2 * cp + (w >> 2);
    const int kt_lo = (2 * cp - 8) < 0 ? 0 : (2 * cp - 8), kt_hi = 2 * cp + 1;
    __syncthreads();
    for (int i = tid; i < 257; i += 512) BL[i] = F.in[I_RELB][h * 257 + i];
#pragma unroll
    for (int k = 0; k < 4; ++k) { const int id = tid + 512 * k, r = id >> 4, ch = id & 15;
        *(LAS v4u*)(QL + r * 136 + ch * 8) = *(const GAS v4u*)(QK + (size_t)(b * SEQ + t0 + r) * 2048 + h * 128 + ch * 8); }
    v4u kreg[2][2], vreg[2][2];
#define ATT_PREFETCH(kt, S) do { _Pragma("unroll") for (int k = 0; k < 2; ++k) { const int id = tid + 512 * k; \
        kreg[S][k] = *(const GAS v4u*)(QK + (size_t)(b * SEQ + (kt) * 64 + (id >> 4)) * 2048 + 1024 + h * 128 + (id & 15) * 8); \
        vreg[S][k] = *(const GAS v4u*)(VT + (size_t)((b * 8 + h) * 128 + (id >> 3)) * 4096 + (kt) * 64 + (id & 7) * 8); } } while (0)
    ATT_PREFETCH(kt_lo, 0); if (kt_lo + 1 <= kt_hi) ATT_PREFETCH(kt_lo + 1, 1);
    f32x4 o[8]; float m_run = -1e30f, l_run = 0.f;
#pragma unroll
    for (int n = 0; n < 8; ++n) o[n] = (f32x4){0.f, 0.f, 0.f, 0.f};
    bf16x8 qf[4];
    for (int kt0 = kt_lo; kt0 <= kt_hi; kt0 += 2)
#pragma unroll
    for (int par = 0; par < 2; ++par) { const int kt = kt0 + par; if (kt > kt_hi) break;
        LDS_WAIT(); __builtin_amdgcn_s_barrier(); asm volatile("" ::: "memory");
#pragma unroll
        for (int k = 0; k < 2; ++k) { const int id = tid + 512 * k; *(LAS v4u*)(KL + (id >> 4) * 136 + (id & 15) * 8) = kreg[par][k]; *(LAS v4u*)(VL + (id >> 3) * 72 + (id & 7) * 8) = vreg[par][k]; }
        LDS_WAIT(); __builtin_amdgcn_s_barrier(); asm volatile("" ::: "memory");
        if (kt == kt_lo) {
#pragma unroll
            for (int ks = 0; ks < 4; ++ks) qf[ks] = *(const LAS bf16x8*)(QL + (16 * w + fr) * 136 + ks * 32 + 8 * fq);
        }
        if (kt + 2 <= kt_hi) ATT_PREFETCH(kt + 2, par);
        if (kt >= cq - 8 && kt <= cq) {
            f32x4 s[4];
#pragma unroll
            for (int n = 0; n < 4; ++n) s[n] = (f32x4){0.f, 0.f, 0.f, 0.f};
#pragma unroll
            for (int ks = 0; ks < 4; ++ks)
#pragma unroll
                for (int n = 0; n < 4; ++n) { const bf16x8 kf = *(const LAS bf16x8*)(KL + (16 * n + fr) * 136 + ks * 32 + 8 * fq); s[n] = MFMA16(kf, qf[ks], s[n]); }
            const int dbase = (t0 + 16 * w + fr) - kt * 64 - 4 * fq;
            float mx = -1e30f;
            if (cq - kt >= 3) {
                const float bfar = BL[256];
#pragma unroll
                for (int n = 0; n < 4; ++n)
#pragma unroll
                    for (int e = 0; e < 4; ++e) { const float v = s[n][e] + bfar; s[n][e] = v; mx = fmaxf(mx, v); }
            } else {
#pragma unroll
                for (int n = 0; n < 4; ++n)
#pragma unroll
                    for (int e = 0; e < 4; ++e) { int d = dbase - 16 * n - e; d = d < -128 ? -128 : (d > 128 ? 128 : d); const float v = s[n][e] + BL[d + 128]; s[n][e] = v; mx = fmaxf(mx, v); }
            }
            mx = fmaxf(mx, __shfl_xor(mx, 16)); mx = fmaxf(mx, __shfl_xor(mx, 32));
            const float m_new = fmaxf(m_run, mx), alpha = __expf(m_run - m_new); float rs = 0.f;
#pragma unroll
            for (int n = 0; n < 4; ++n) { const float p0 = __expf(s[n][0] - m_new), p1 = __expf(s[n][1] - m_new), p2 = __expf(s[n][2] - m_new), p3 = __expf(s[n][3] - m_new);
                rs += (p0 + p1) + (p2 + p3); u32x2 pw; pw.x = pk2(p0, p1); pw.y = pk2(p2, p3);
                *(LAS u32x2*)(PL + (w * 16 + fr) * 72 + 16 * n + 4 * fq) = pw; }
            rs += __shfl_xor(rs, 16); rs += __shfl_xor(rs, 32);
            l_run = l_run * alpha + rs; m_run = m_new;
#pragma unroll
            for (int n = 0; n < 8; ++n) o[n] = o[n] * alpha;
            LDS_WAIT();
#pragma unroll
            for (int ks = 0; ks < 2; ++ks) { const bf16x8 pf = *(const LAS bf16x8*)(PL + (w * 16 + fr) * 72 + ks * 32 + 8 * fq);
#pragma unroll
                for (int n = 0; n < 8; ++n) { const bf16x8 vf = *(const LAS bf16x8*)(VL + (16 * n + fr) * 72 + ks * 32 + 8 * fq); o[n] = MFMA16(vf, pf, o[n]); } }
        }
    }
#undef ATT_PREFETCH
    const float inv = 64.0f / l_run; unsigned char* orow = (unsigned char*)YB + (size_t)(b * SEQ + t0 + 16 * w + fr) * 1024 + h * 128 + 4 * fq;
#pragma unroll
    for (int n = 0; n < 8; ++n) { int a = 0; a = __builtin_amdgcn_cvt_pk_fp8_f32(o[n][0] * inv, o[n][1] * inv, a, false); a = __builtin_amdgcn_cvt_pk_fp8_f32(o[n][2] * inv, o[n][3] * inv, a, true); *(GAS unsigned*)(orow + 16 * n) = (unsigned)a; }
}

DI void score_unit(Frame& F, int unit) {
    const int p = unit & 1, h = (unit >> 1) & 7, tt = unit >> 4, lane = F.lane, w = F.wave, fr = lane & 15, fq = lane >> 4;
    const bf16* PQ = (const bf16*)(F.ws + WS_S0); const bf16* SK = (const bf16*)(F.ws + WS_SUBK) + (size_t)p * 128 * 128; float* SC = (float*)(F.ws + WS_S2);
    const int tok = tt * 128 + 16 * w + fr;
    f32x4 s[8];
#pragma unroll
    for (int n = 0; n < 8; ++n) s[n] = (f32x4){0.f, 0.f, 0.f, 0.f};
#pragma unroll
    for (int ks = 0; ks < 4; ++ks) { const bf16x8 af = *(const GAS bf16x8*)(PQ + (size_t)tok * 2048 + h * 256 + p * 128 + ks * 32 + 8 * fq);
#pragma unroll
        for (int n = 0; n < 8; ++n) { const bf16x8 kf = *(const GAS bf16x8*)(SK + (size_t)(16 * n + fr) * 128 + ks * 32 + 8 * fq); s[n] = MFMA16(kf, af, s[n]); } }
    const size_t v = (size_t)(h * 2 + p) * TOK + tok;
#pragma unroll
    for (int n = 0; n < 8; ++n) *(GAS f32x4*)(SC + ((size_t)(4 * n + fq) * (TOK * 16) + v) * 4) = s[n];
}

DI unsigned key_of(float v) { unsigned u = __builtin_bit_cast(unsigned, v); return u ^ ((unsigned)((int)u >> 31) | 0x80000000u); }
DI float val_of(unsigned k) { const unsigned u = (k & 0x80000000u) ? (k ^ 0x80000000u) : ~k; return __builtin_bit_cast(float, u); }
DI unsigned idx7(unsigned long long lo, unsigned long long hi, int i) { const bool first = i < 9; const unsigned long long w = first ? lo : hi; return (unsigned)(w >> (7 * (first ? i : i - 9))) & 127u; }
#define RB_CE(V, a, b) { const unsigned hi_ = V[a] > V[b] ? V[a] : V[b]; V[b] = V[a] > V[b] ? V[b] : V[a]; V[a] = hi_; }
#define RB_SORT16(V) do { RB_CE(V, 0, 1) RB_CE(V, 3, 2) RB_CE(V, 4, 5) RB_CE(V, 7, 6) RB_CE(V, 8, 9) RB_CE(V, 11, 10) RB_CE(V, 12, 13) RB_CE(V, 15, 14) RB_CE(V, 0, 2) RB_CE(V, 1, 3) RB_CE(V, 6, 4) RB_CE(V, 7, 5) RB_CE(V, 8, 10) RB_CE(V, 9, 11) RB_CE(V, 14, 12) RB_CE(V, 15, 13) RB_CE(V, 0, 1) RB_CE(V, 2, 3) RB_CE(V, 5, 4) RB_CE(V, 7, 6) RB_CE(V, 8, 9) RB_CE(V, 10, 11) RB_CE(V, 13, 12) RB_CE(V, 15, 14) RB_CE(V, 0, 4) RB_CE(V, 1, 5) RB_CE(V, 2, 6) RB_CE(V, 3, 7) RB_CE(V, 12, 8) RB_CE(V, 13, 9) RB_CE(V, 14, 10) RB_CE(V, 15, 11) RB_CE(V, 0, 2) RB_CE(V, 1, 3) RB_CE(V, 4, 6) RB_CE(V, 5, 7) RB_CE(V, 10, 8) RB_CE(V, 11, 9) RB_CE(V, 14, 12) RB_CE(V, 15, 13) RB_CE(V, 0, 1) RB_CE(V, 2, 3) RB_CE(V, 4, 5) RB_CE(V, 6, 7) RB_CE(V, 9, 8) RB_CE(V, 11, 10) RB_CE(V, 13, 12) RB_CE(V, 15, 14) RB_CE(V, 0, 8) RB_CE(V, 1, 9) RB_CE(V, 2, 10) RB_CE(V, 3, 11) RB_CE(V, 4, 12) RB_CE(V, 5, 13) RB_CE(V, 6, 14) RB_CE(V, 7, 15) RB_CE(V, 0, 4) RB_CE(V, 1, 5) RB_CE(V, 2, 6) RB_CE(V, 3, 7) RB_CE(V, 8, 12) RB_CE(V, 9, 13) RB_CE(V, 10, 14) RB_CE(V, 11, 15) RB_CE(V, 0, 2) RB_CE(V, 1, 3) RB_CE(V, 4, 6) RB_CE(V, 5, 7) RB_CE(V, 8, 10) RB_CE(V, 9, 11) RB_CE(V, 12, 14) RB_CE(V, 13, 15) RB_CE(V, 0, 1) RB_CE(V, 2, 3) RB_CE(V, 4, 5) RB_CE(V, 6, 7) RB_CE(V, 8, 9) RB_CE(V, 10, 11) RB_CE(V, 12, 13) RB_CE(V, 14, 15) } while (0)
#define RB_MERGE16(V) do { RB_CE(V, 0, 8) RB_CE(V, 1, 9) RB_CE(V, 2, 10) RB_CE(V, 3, 11) RB_CE(V, 4, 12) RB_CE(V, 5, 13) RB_CE(V, 6, 14) RB_CE(V, 7, 15) RB_CE(V, 0, 4) RB_CE(V, 1, 5) RB_CE(V, 2, 6) RB_CE(V, 3, 7) RB_CE(V, 8, 12) RB_CE(V, 9, 13) RB_CE(V, 10, 14) RB_CE(V, 11, 15) RB_CE(V, 0, 2) RB_CE(V, 1, 3) RB_CE(V, 4, 6) RB_CE(V, 5, 7) RB_CE(V, 8, 10) RB_CE(V, 9, 11) RB_CE(V, 12, 14) RB_CE(V, 13, 15) RB_CE(V, 0, 1) RB_CE(V, 2, 3) RB_CE(V, 4, 5) RB_CE(V, 6, 7) RB_CE(V, 8, 9) RB_CE(V, 10, 11) RB_CE(V, 12, 13) RB_CE(V, 14, 15) } while (0)
DI void route_block(Frame& F, int ib) {
    const int lane = F.lane, hh = ib >> 8, t0 = (ib & 255) * 32, p = lane >> 5, t = t0 + (lane & 31);
    const float* SC = (const float*)(F.ws + WS_S2);
    const size_t v = (size_t)(hh * 2 + p) * TOK + t;
    unsigned A[16];
#pragma unroll 1
    for (int g = 0; g < 8; ++g) {
        unsigned N[16];
#pragma unroll
        for (int c = 0; c < 4; ++c) { const f32x4 s = *(const GAS f32x4*)(SC + ((size_t)(4 * g + c) * (TOK * 16) + v) * 4);
#pragma unroll
            for (int e = 0; e < 4; ++e) N[4 * c + e] = (key_of(s[e]) & ~127u) | (unsigned)(16 * g + 4 * c + e); }
        RB_SORT16(N);
        if (g == 0) {
#pragma unroll
            for (int k = 0; k < 16; ++k) A[k] = N[k];
        } else {
#pragma unroll
            for (int k = 0; k < 16; ++k) A[k] = A[k] > N[15 - k] ? A[k] : N[15 - k];
            RB_MERGE16(A);
        }
    }
    unsigned B[16];
#pragma unroll
    for (int k = 0; k < 16; ++k) B[k] = (unsigned)__shfl((int)A[k], (lane & 31) + 32);
    float va[16], vb[16]; unsigned long long alo = 0, ahi = 0, blo = 0, bhi = 0;
#pragma unroll
    for (int k = 0; k < 16; ++k) { va[k] = val_of(A[k] & ~127u); vb[k] = val_of(B[k] & ~127u);
        if (k < 9) { alo |= (unsigned long long)(A[k] & 127u) << (7 * k); blo |= (unsigned long long)(B[k] & 127u) << (7 * k); }
        else { ahi |= (unsigned long long)(A[k] & 127u) << (7 * (k - 9)); bhi |= (unsigned long long)(B[k] & 127u) << (7 * (k - 9)); } }
    unsigned C[16];
#pragma unroll
    for (int k = 0; k < 16; ++k) C[k] = 0u;
#pragma unroll
    for (int i = 0; i < 16; ++i)
#pragma unroll
        for (int j = 0; j < 16; ++j) if ((i + 1) * (j + 1) <= 16) { unsigned x = (key_of(va[i] + vb[j]) & ~255u) | (unsigned)(i * 16 + j);
#pragma unroll
            for (int k = (i + 1) * (j + 1) - 1; k < 16; ++k) { const unsigned hi_ = C[k] > x ? C[k] : x; x = C[k] > x ? x : C[k]; C[k] = hi_; } }
    float ev[16]; int ex[16]; float sum = 0.f; const float top = val_of(C[0] & ~255u);
#pragma unroll
    for (int r = 0; r < 16; ++r) { const int ij = (int)(C[r] & 255u); ev[r] = __expf(val_of(C[r] & ~255u) - top); sum += ev[r];
        ex[r] = (int)(idx7(alo, ahi, ij >> 4) * 128u + idx7(blo, bhi, ij & 15)); }
    const float inv = 1.0f / sum;
    if (lane < 32) {
        int* EI = (int*)(F.ws + WS_S4) + ((size_t)t * 8 + hh) * 16; float* EG = (float*)(F.ws + WS_S4 + 4 * MiB) + ((size_t)t * 8 + hh) * 16;
#pragma unroll
        for (int r = 0; r < 16; r += 4) { *(GAS v4u*)(EI + r) = (v4u){(unsigned)ex[r], (unsigned)ex[r + 1], (unsigned)ex[r + 2], (unsigned)ex[r + 3]};
            *(GAS f32x4*)(EG + r) = (f32x4){ev[r] * inv, ev[r + 1] * inv, ev[r + 2] * inv, ev[r + 3] * inv}; }
    }
}

typedef float f32x2p __attribute__((ext_vector_type(2)));
typedef __bf16 bf16x2p __attribute__((ext_vector_type(2)));
struct PeerTok { unsigned xn[16]; f32x2p acc[16]; int e_lo, e_hi; float g_lo, g_hi; };
DI void peer_open(Frame& F, PeerTok& T, int t, LAS unsigned* wl) {
    const int lane = F.lane; int l32 = 4 * F.lane; asm volatile("" : "+v"(l32));
    const bf16* Hrow = (const bf16*)(F.ws + WS_S6) + (size_t)t * DM;
    f32x4 hv[8]; float ss = 0.f;
#pragma unroll
    for (int k = 0; k < 8; ++k) { const u32x2 hw = *(const GAS u32x2*)(Hrow + l32 + 256 * k); hv[k] = (f32x4){bflo(hw.x), bfhi(hw.x), bflo(hw.y), bfhi(hw.y)}; const f32x4 a = hv[k]; ss += (a.x * a.x + a.y * a.y) + (a.z * a.z + a.w * a.w); }
    const float rstd = 1.0f / sqrtf(wave_sum(ss) * (1.f / DM) + EPS);
#pragma unroll
    for (int k = 0; k < 8; ++k) { const f32x4 g = *(const GAS f32x4*)(F.in[I_GFFN] + l32 + 256 * k); const f32x4 a = hv[k];
        T.xn[2 * k] = pk2(a.x * rstd * g.x, a.y * rstd * g.y); T.xn[2 * k + 1] = pk2(a.z * rstd * g.z, a.w * rstd * g.w); }
#pragma unroll
    for (int i = 0; i < 16; ++i) T.acc[i] = (f32x2p){0.f, 0.f};
    const int* EI = (const int*)(F.ws + WS_S4) + (size_t)t * 128; const float* EG = (const float*)(F.ws + WS_S4 + 4 * MiB) + (size_t)t * 128;
    const int e0 = EI[lane], e1 = EI[64 + lane]; const float g0 = EG[lane], g1 = EG[64 + lane];
    wl[lane] = 0u; wl[64 + lane] = 0u; LDS_WAIT();
    const unsigned o0 = __hip_atomic_fetch_add(wl + (e0 >> 7), 1u, __ATOMIC_RELAXED, __HIP_MEMORY_SCOPE_WAVEFRONT);
    const unsigned o1 = __hip_atomic_fetch_add(wl + (e1 >> 7), 1u, __ATOMIC_RELAXED, __HIP_MEMORY_SCOPE_WAVEFRONT);
    LDS_WAIT();
    const int c0 = (int)wl[lane], c1 = (int)wl[64 + lane];
    int i0 = c0, i1 = c1;
#pragma unroll
    for (int o = 1; o < 64; o <<= 1) { const int t0 = __shfl_up(i0, o), t1 = __shfl_up(i1, o); if (lane >= o) { i0 += t0; i1 += t1; } }
    const int tot0 = __shfl(i0, 63);
    wl[128 + lane] = (unsigned)(i0 - c0); wl[192 + lane] = (unsigned)(tot0 + i1 - c1); LDS_WAIT();
    const unsigned p0 = wl[128 + (e0 >> 7)] + o0, p1 = wl[128 + (e1 >> 7)] + o1; LDS_WAIT();
    wl[256 + 2 * p0] = (unsigned)e0; wl[256 + 2 * p0 + 1] = __builtin_bit_cast(unsigned, g0); wl[256 + 2 * p1] = (unsigned)e1; wl[256 + 2 * p1 + 1] = __builtin_bit_cast(unsigned, g1); LDS_WAIT();
    T.e_lo = (int)wl[256 + 2 * lane]; T.g_lo = __builtin_bit_cast(float, wl[256 + 2 * lane + 1]); T.e_hi = (int)wl[256 + 2 * (64 + lane)]; T.g_hi = __builtin_bit_cast(float, wl[256 + 2 * (64 + lane) + 1]); LDS_WAIT();
}
DI void peer_close(Frame& F, PeerTok& T, int t) {
    int l16 = 4 * F.lane; asm volatile("" : "+v"(l16));
    const bf16* Hrow = (const bf16*)(F.ws + WS_S6) + (size_t)t * DM;
    float s3 = 0.f;
#pragma unroll
    for (int k = 0; k < 8; ++k) { const u32x2 hw = *(const GAS u32x2*)(Hrow + l16 + 256 * k); const f32x4 a = (f32x4){bflo(hw.x), bfhi(hw.x), bflo(hw.y), bfhi(hw.y)};
        T.acc[2 * k] += (f32x2p){a.x, a.y}; T.acc[2 * k + 1] += (f32x2p){a.z, a.w};
        s3 += (T.acc[2 * k].x * T.acc[2 * k].x + T.acc[2 * k].y * T.acc[2 * k].y) + (T.acc[2 * k + 1].x * T.acc[2 * k + 1].x + T.acc[2 * k + 1].y * T.acc[2 * k + 1].y); }
    const float r3 = 1.0f / sqrtf(wave_sum(s3) * (1.f / DM) + EPS);
    float* orow = F.out + (size_t)t * DM;
#pragma unroll
    for (int k = 0; k < 8; ++k) { const f32x4 g = *(const GAS f32x4*)(F.in[I_GFIN] + l16 + 256 * k);
        *(GAS f32x4*)(orow + l16 + 256 * k) = (f32x4){T.acc[2 * k].x * r3 * g.x, T.acc[2 * k].y * r3 * g.y, T.acc[2 * k + 1].x * r3 * g.z, T.acc[2 * k + 1].y * r3 * g.w}; }
}
template <bool DESC> DI void peer_pair(Frame& F, int tA, int tB) {
    const int lane = F.lane;
    const unsigned char* PU4 = F.ws + WS_PU; const unsigned char* PV4 = F.ws + WS_PU + 16 * MiB; const float* FS = (const float*)(F.ws + WS_PU + 64 * MiB);
    LAS unsigned* wl = (LAS unsigned*)(F.lds + F.wave * 2048);
    PeerTok A, B;
    peer_open(F, A, tA, wl); peer_open(F, B, tB, wl);
#if defined(DBG_STAMP)
    constexpr int PG = (DBG_STAMP >= 0) ? 2 : 4;
#else
    constexpr int PG = 4;
#endif
    v4u ua[PG], ub[PG], vv[PG];
#define PEER_EX(T, k) __builtin_amdgcn_readlane((k) < 64 ? T.e_lo : T.e_hi, (k) & 63)
#define PEER_LOADU(T, dst, k0) do { _Pragma("unroll") for (int q = 0; q < PG; ++q) { const int e = PEER_EX(T, (k0) + q); dst[q] = *(const GAS v4u*)(PU4 + (size_t)e * 1024 + 16 * lane); } } while (0)
#define PEER_GROUP(T, ucur, k0) do { \
        int ex[PG]; float gt[PG]; \
        _Pragma("unroll") for (int q = 0; q < PG; ++q) { ex[q] = PEER_EX(T, (k0) + q); gt[q] = __builtin_bit_cast(float, __builtin_amdgcn_readlane(__builtin_bit_cast(int, (k0) < 64 ? T.g_lo : T.g_hi), ((k0) + q) & 63)); \
            vv[q] = *(const GAS v4u*)(PV4 + (size_t)ex[q] * 1024 + 16 * lane); } \
        float act[PG]; \
        _Pragma("unroll") for (int q = 0; q < PG; ++q) { float d = 0.f; const v4u u = ucur[q]; const unsigned w4[4] = {u.x, u.y, u.z, u.w}; \
            _Pragma("unroll") for (int c = 0; c < 4; ++c) { \
                d = __builtin_amdgcn_fdot2_f32_bf16(__builtin_amdgcn_cvt_scalef32_pk_bf16_fp4(w4[c], 1.0f, 0), __builtin_bit_cast(bf16x2p, T.xn[4 * c + 0]), d, false); \
                d = __builtin_amdgcn_fdot2_f32_bf16(__builtin_amdgcn_cvt_scalef32_pk_bf16_fp4(w4[c], 1.0f, 1), __builtin_bit_cast(bf16x2p, T.xn[4 * c + 1]), d, false); \
                d = __builtin_amdgcn_fdot2_f32_bf16(__builtin_amdgcn_cvt_scalef32_pk_bf16_fp4(w4[c], 1.0f, 2), __builtin_bit_cast(bf16x2p, T.xn[4 * c + 2]), d, false); \
                d = __builtin_amdgcn_fdot2_f32_bf16(__builtin_amdgcn_cvt_scalef32_pk_bf16_fp4(w4[c], 1.0f, 3), __builtin_bit_cast(bf16x2p, T.xn[4 * c + 3]), d, false); } \
            act[q] = d; __builtin_amdgcn_sched_barrier(0); } \
        if (DESC ? (k0) - PG >= 0 : (k0) + PG < 128) PEER_LOADU(T, ucur, DESC ? (k0) - PG : (k0) + PG); \
        _Pragma("unroll") for (int o = 1; o < 64; o <<= 1) { _Pragma("unroll") for (int q = 0; q < PG; ++q) act[q] += __shfl_xor(act[q], o); } \
        _Pragma("unroll") for (int q = 0; q < PG; ++q) { const float a = gelu1(act[q] * FS[ex[q]]) * gt[q] * FS[16384 + ex[q]]; const f32x2p a2 = (f32x2p){a, a}; \
            const v4u v = vv[q]; const unsigned w4[4] = {v.x, v.y, v.z, v.w}; \
            _Pragma("unroll") for (int c = 0; c < 4; ++c) { T.acc[4 * c + 0] += a2 * __builtin_amdgcn_cvt_scalef32_pk_f32_fp4(w4[c], 1.0f, 0); T.acc[4 * c + 1] += a2 * __builtin_amdgcn_cvt_scalef32_pk_f32_fp4(w4[c], 1.0f, 1); \
                T.acc[4 * c + 2] += a2 * __builtin_amdgcn_cvt_scalef32_pk_f32_fp4(w4[c], 1.0f, 2); T.acc[4 * c + 3] += a2 * __builtin_amdgcn_cvt_scalef32_pk_f32_fp4(w4[c], 1.0f, 3); } __builtin_amdgcn_sched_barrier(0); } \
    } while (0)
    if (DESC) { PEER_LOADU(A, ua, 128 - PG); PEER_LOADU(B, ub, 128 - PG); for (int k0 = 128 - PG; k0 >= 0; k0 -= PG) { PEER_GROUP(A, ua, k0); PEER_GROUP(B, ub, k0); } }
    else { PEER_LOADU(A, ua, 0); PEER_LOADU(B, ub, 0); for (int k0 = 0; k0 < 128; k0 += PG) { PEER_GROUP(A, ua, k0); PEER_GROUP(B, ub, k0); } }
#undef PEER_GROUP
#undef PEER_LOADU
#undef PEER_EX
    peer_close(F, A, tA); peer_close(F, B, tB);
}

typedef int v8i __attribute__((ext_vector_type(8)));
typedef unsigned v8u __attribute__((ext_vector_type(8)));
#ifndef P3_SELFTEST
#define P3_SELFTEST 0
#endif
#ifndef P3_PROBE_P
#define P3_PROBE_P 32
#endif
constexpr int P3_SLICE = 16640, P3_ROWS = 8192, P3_RSTR = 1040;
DI void peer_open3(Frame& F, int t, int ti, LAS unsigned char* slice) {
    int lane = F.lane; asm volatile("" : "+v"(lane)); const int l32 = 4 * lane;
    const bf16* Hrow = (const bf16*)(F.ws + WS_S6) + (size_t)t * DM; const float* FS = (const float*)(F.ws + WS_PU + 64 * MiB);
    f32x4 hv[8]; float ss = 0.f;
#pragma unroll
    for (int k = 0; k < 8; ++k) { const u32x2 hw = *(const GAS u32x2*)(Hrow + l32 + 256 * k); hv[k] = (f32x4){bflo(hw.x), bfhi(hw.x), bflo(hw.y), bfhi(hw.y)}; const f32x4 a = hv[k]; ss += (a.x * a.x + a.y * a.y) + (a.z * a.z + a.w * a.w); }
    const float r16 = 16.0f / sqrtf(wave_sum(ss) * (1.f / DM) + EPS);
    unsigned w8[8];
#pragma unroll
    for (int k = 0; k < 8; ++k) { const f32x4 g = *(const GAS f32x4*)(F.in[I_GFFN] + l32 + 256 * k); const f32x4 a = hv[k]; int p = 0;
        p = __builtin_amdgcn_cvt_pk_fp8_f32(a.x * r16 * g.x, a.y * r16 * g.y, p, false); p = __builtin_amdgcn_cvt_pk_fp8_f32(a.z * r16 * g.z, a.w * r16 * g.w, p, true); w8[k] = (unsigned)p; }
    *(LAS v4u*)(slice + ti * 2048 + lane * 32) = (v4u){w8[0], w8[1], w8[2], w8[3]}; *(LAS v4u*)(slice + ti * 2048 + lane * 32 + 16) = (v4u){w8[4], w8[5], w8[6], w8[7]};
    LAS unsigned* wl = (LAS unsigned*)(slice + 7168);
    LAS unsigned* E = (LAS unsigned*)(slice + 4096 + ti * 1536); LAS float* SU = (LAS float*)(E + 128); LAS float* GV = SU + 128;
    const int* EI = (const int*)(F.ws + WS_S4) + (size_t)t * 128; const float* EG = (const float*)(F.ws + WS_S4 + 4 * MiB) + (size_t)t * 128;
    const int e0 = EI[lane], e1 = EI[64 + lane]; const float g0 = EG[lane], g1 = EG[64 + lane];
    const float su0 = FS[e0] * 0.0625f, su1 = FS[e1] * 0.0625f, gv0 = g0 * FS[16384 + e0], gv1 = g1 * FS[16384 + e1];
    wl[lane] = 0u; wl[64 + lane] = 0u; LDS_WAIT();
    const unsigned o0 = __hip_atomic_fetch_add(wl + (e0 >> 7), 1u, __ATOMIC_RELAXED, __HIP_MEMORY_SCOPE_WAVEFRONT);
    const unsigned o1 = __hip_atomic_fetch_add(wl + (e1 >> 7), 1u, __ATOMIC_RELAXED, __HIP_MEMORY_SCOPE_WAVEFRONT);
    LDS_WAIT();
    const int c0 = (int)wl[lane], c1 = (int)wl[64 + lane];
    int i0 = c0, i1 = c1;
#pragma unroll
    for (int o = 1; o < 64; o <<= 1) { const int t0 = __shfl_up(i0, o), t1 = __shfl_up(i1, o); if (lane >= o) { i0 += t0; i1 += t1; } }
    const int tot0 = __shfl(i0, 63);
    wl[128 + lane] = (unsigned)(i0 - c0); wl[192 + lane] = (unsigned)(tot0 + i1 - c1); LDS_WAIT();
    const unsigned p0 = wl[128 + (e0 >> 7)] + o0, p1 = wl[128 + (e1 >> 7)] + o1; LDS_WAIT();
    E[p0] = (unsigned)e0; SU[p0] = su0; GV[p0] = gv0; E[p1] = (unsigned)e1; SU[p1] = su1; GV[p1] = gv1; LDS_WAIT();
}
DI void peer_close3(Frame& F, f32x2p* acc, int t) {
    int l16 = 4 * F.lane; asm volatile("" : "+v"(l16));
    const bf16* Hrow = (const bf16*)(F.ws + WS_S6) + (size_t)t * DM;
    float s3 = 0.f;
#pragma unroll
    for (int k = 0; k < 8; ++k) { const u32x2 hw = *(const GAS u32x2*)(Hrow + l16 + 256 * k); const f32x4 a = (f32x4){bflo(hw.x), bfhi(hw.x), bflo(hw.y), bfhi(hw.y)};
        acc[2 * k] += (f32x2p){a.x, a.y}; acc[2 * k + 1] += (f32x2p){a.z, a.w};
        s3 += (acc[2 * k].x * acc[2 * k].x + acc[2 * k].y * acc[2 * k].y) + (acc[2 * k + 1].x * acc[2 * k + 1].x + acc[2 * k + 1].y * acc[2 * k + 1].y); }
    const float r3 = 1.0f / sqrtf(wave_sum(s3) * (1.f / DM) + EPS);
    float* orow = F.out + (size_t)t * DM;
#pragma unroll
    for (int k = 0; k < 8; ++k) { const f32x4 g = *(const GAS f32x4*)(F.in[I_GFIN] + l16 + 256 * k);
        __builtin_nontemporal_store((f32x4){acc[2 * k].x * r3 * g.x, acc[2 * k].y * r3 * g.y, acc[2 * k + 1].x * r3 * g.z, acc[2 * k + 1].y * r3 * g.w}, (GAS f32x4*)(orow + l16 + 256 * k)); }
}
template <bool DESC> DI void peer_pair3(Frame& F, int tA, int tB) {
    int lane = F.lane; asm volatile("" : "+v"(lane));
    const int kq = lane >> 4;
    const unsigned char* PU4 = F.ws + WS_PU; const unsigned char* PV4 = F.ws + WS_PU + 16 * MiB;
    LAS unsigned char* slice = F.lds + F.wave * P3_SLICE;
    peer_open3(F, tA, 0, slice); peer_open3(F, tB, 1, slice);
    f32x2p accA[16], accB[16];
#pragma unroll
    for (int i = 0; i < 16; ++i) { accA[i] = (f32x2p){0.f, 0.f}; accB[i] = (f32x2p){0.f, 0.f}; }
    const LAS unsigned* Eb = (const LAS unsigned*)(slice + 4096 + ((lane >> 2) & 1) * 1536) + (lane & 3);
    const LAS float* SUl = (const LAS float*)(slice + 4096 + (kq & 1) * 1536 + 512);
    const LAS float* GVl = SUl + 128;
    const LAS unsigned char* arow = slice + P3_ROWS + (lane & 7) * P3_RSTR + kq * 16;
    const LAS unsigned char* xb = slice + (lane & 1) * 2048 + (kq >> 1) * 32 + (kq & 1) * 16;
    v4u v0[8], v1[8]; float diag = 0.f; unsigned unit_sc = 0x7F7F7F7Fu; asm volatile("" : "+v"(unit_sc));
#define P3_B(i) (DESC ? 31 - (i) : (i))
#define P3_ISSUE_A(EV) do { _Pragma("unroll") for (int j = 0; j < 8; ++j) { const unsigned e_ = (unsigned)__builtin_amdgcn_readlane((int)(EV), j); \
        __builtin_amdgcn_global_load_lds((const unsigned*)(PU4 + (size_t)e_ * 1024 + 16 * lane), (LAS unsigned*)(slice + P3_ROWS + j * P3_RSTR), 16, 0, 0); } } while (0)
#define P3_ISSUE_V(V, EV) do { _Pragma("unroll") for (int j = 0; j < 8; ++j) { const unsigned e_ = (unsigned)__builtin_amdgcn_readlane((int)(EV), j); V[j] = *(const GAS v4u*)(PV4 + (size_t)e_ * 1024 + 16 * lane); } } while (0)
#define P3_BATCH(i, VC, VN) do { \
        const int b_ = P3_B(i), bn_ = P3_B((i) + 1 < 32 ? (i) + 1 : (i)); \
        const f32x4 su = *(const LAS f32x4*)(SUl + 4 * b_), gv = *(const LAS f32x4*)(GVl + 4 * b_); const unsigned evn = Eb[4 * bn_]; \
        asm volatile("s_waitcnt vmcnt(8)" ::: "memory"); \
        f32x4 D = {0.f, 0.f, 0.f, 0.f}; asm volatile("s_nop 3" : "+v"(D)); \
        _Pragma("unroll") for (int s = 0; s < 16; ++s) { const v4u a_ = *(const LAS v4u*)(arow + 64 * s); const v4u b0 = *(const LAS v4u*)(xb + 128 * s), b1 = *(const LAS v4u*)(xb + 128 * s + 64); \
            const v8u b_ = (v8u){b0.x, b0.y, b0.z, b0.w, b1.x, b1.y, b1.z, b1.w}; asm volatile("v_mfma_scale_f32_16x16x128_f8f6f4 %0, %1, %2, %0, %3, %3 op_sel_hi:[0,0,0] cbsz:4" : "+v"(D) : "v"(a_), "v"(b_), "v"(unit_sc)); } \
        asm volatile("s_nop 15\n\ts_nop 15" : "+v"(D)); \
        float ac[4]; \
        _Pragma("unroll") for (int q = 0; q < 4; ++q) ac[q] = gelu1(D[q] * su[q]) * gv[q]; \
        LDS_WAIT(); \
        P3_ISSUE_A(evn); P3_ISSUE_V(VN, evn); \
        _Pragma("unroll") for (int j = 0; j < 8; ++j) { const float a = __builtin_bit_cast(float, __builtin_amdgcn_readlane(__builtin_bit_cast(int, ac[j & 3]), 17 * (j >> 2))); const f32x2p a2 = (f32x2p){a, a}; \
            const v4u v = VC[j]; const unsigned w4[4] = {v.x, v.y, v.z, v.w}; \
            _Pragma("unroll") for (int c = 0; c < 4; ++c) { \
                if (j < 4) { accA[4 * c + 0] += a2 * __builtin_amdgcn_cvt_scalef32_pk_f32_fp4(w4[c], 1.0f, 0); accA[4 * c + 1] += a2 * __builtin_amdgcn_cvt_scalef32_pk_f32_fp4(w4[c], 1.0f, 1); \
                    accA[4 * c + 2] += a2 * __builtin_amdgcn_cvt_scalef32_pk_f32_fp4(w4[c], 1.0f, 2); accA[4 * c + 3] += a2 * __builtin_amdgcn_cvt_scalef32_pk_f32_fp4(w4[c], 1.0f, 3); } \
                else { accB[4 * c + 0] += a2 * __builtin_amdgcn_cvt_scalef32_pk_f32_fp4(w4[c], 1.0f, 0); accB[4 * c + 1] += a2 * __builtin_amdgcn_cvt_scalef32_pk_f32_fp4(w4[c], 1.0f, 1); \
                    accB[4 * c + 2] += a2 * __builtin_amdgcn_cvt_scalef32_pk_f32_fp4(w4[c], 1.0f, 2); accB[4 * c + 3] += a2 * __builtin_amdgcn_cvt_scalef32_pk_f32_fp4(w4[c], 1.0f, 3); } } } \
    } while (0)
    { const unsigned ev = Eb[4 * P3_B(0)]; P3_ISSUE_A(ev); P3_ISSUE_V(v0, ev); }
        if (P3_SELFTEST) { if (!DESC && blockIdx.x == 0 && F.wave == 0) {
            asm volatile("s_waitcnt vmcnt(0)" ::: "memory");
            unsigned B1[8], B2[8];
#pragma unroll
            for (int w = 0; w < 8; ++w) { const int id0 = kq * 32 + 4 * w; int p1 = 0, p2 = 0;
                p1 = __builtin_amdgcn_cvt_pk_fp8_f32((float)((id0 + 0) & 7), (float)((id0 + 1) & 7), p1, false); p1 = __builtin_amdgcn_cvt_pk_fp8_f32((float)((id0 + 2) & 7), (float)((id0 + 3) & 7), p1, true);
                p2 = __builtin_amdgcn_cvt_pk_fp8_f32((float)((id0 + 0) >> 3), (float)((id0 + 1) >> 3), p2, false); p2 = __builtin_amdgcn_cvt_pk_fp8_f32((float)((id0 + 2) >> 3), (float)((id0 + 3) >> 3), p2, true);
                B1[w] = (unsigned)p1; B2[w] = (unsigned)p2; }
            const v8u b1_ = (v8u){B1[0], B1[1], B1[2], B1[3], B1[4], B1[5], B1[6], B1[7]}, b2_ = (v8u){B2[0], B2[1], B2[2], B2[3], B2[4], B2[5], B2[6], B2[7]};
            int c1 = 0, c2 = 0, c3 = 0, c4 = 0, c5 = 0, c6 = 0, id01 = 0, idq = 0;
#pragma nounroll
            for (int p = 0; p < 128; ++p) { const int g0 = p >> 5, n0 = p & 31;
                const unsigned hot = (lane == 16 * g0) ? (0x2u << (4 * (n0 & 7))) : 0u; const int wsel = n0 >> 3;
                v4u a_ = (v4u){wsel == 0 ? hot : 0u, wsel == 1 ? hot : 0u, wsel == 2 ? hot : 0u, wsel == 3 ? hot : 0u};
                f32x4 D1 = {0.f, 0.f, 0.f, 0.f}, D2 = {0.f, 0.f, 0.f, 0.f}; asm volatile("s_nop 15\n\ts_nop 15" : "+v"(D1), "+v"(D2), "+v"(a_));
                asm volatile("v_mfma_scale_f32_16x16x128_f8f6f4 %0, %1, %2, %0, %3, %3 op_sel_hi:[0,0,0] cbsz:4" : "+v"(D1) : "v"(a_), "v"(b1_), "v"(unit_sc));
                asm volatile("v_mfma_scale_f32_16x16x128_f8f6f4 %0, %1, %2, %0, %3, %3 op_sel_hi:[0,0,0] cbsz:4" : "+v"(D2) : "v"(a_), "v"(b2_), "v"(unit_sc));
                asm volatile("s_nop 15\n\ts_nop 15\n\ts_nop 15" : "+v"(D1), "+v"(D2));
                const int idp = (int)__builtin_bit_cast(float, __builtin_amdgcn_readlane(__builtin_bit_cast(int, D2[0]), 0)) * 8 + (int)__builtin_bit_cast(float, __builtin_amdgcn_readlane(__builtin_bit_cast(int, D1[0]), 0));
                const int kA0 = 32 * g0 + n0, kA1 = 32 * g0 + (n0 ^ 1), kA2 = 64 * (n0 >> 4) + 16 * g0 + (n0 & 15), kA3 = 64 * (n0 >> 4) + 16 * g0 + ((n0 ^ 1) & 15);
                const int ib0 = ((kA0 >> 4) & 3) * 32 + 16 * (kA0 >> 6) + (kA0 & 15), ib1 = ((kA1 >> 4) & 3) * 32 + 16 * (kA1 >> 6) + (kA1 & 15);
                c1 += (idp == ib0); c2 += (idp == ib1); c3 += (idp == kA2); c4 += (idp == kA3); c5 += (idp == kA0); c6 += (idp == kA1);
                if (p == 1) id01 = idp; if (p == P3_PROBE_P) idq = idp; }
            const int cf = c1 == 128 ? 1 : c2 == 128 ? 2 : c3 == 128 ? 3 : c4 == 128 ? 4 : c5 == 128 ? 5 : c6 == 128 ? 6 : 0;
            diag = (float)(20 + 2 * (P3_SELFTEST == 1 ? (cf ? cf : 7 + (id01 & 31)) : P3_SELFTEST == 2 ? (c5 >> 2) : P3_SELFTEST == 3 ? (idq >> 2) : (idq & 31))); } }
    for (int i = 0; i < 32; i += 2) { P3_BATCH(i, v0, v1); P3_BATCH(i + 1, v1, v0); }
    asm volatile("s_waitcnt vmcnt(0)" ::: "memory");
#undef P3_BATCH
#undef P3_ISSUE_V
#undef P3_ISSUE_A
#undef P3_B
    peer_close3(F, accA, tA); peer_close3(F, accB, tB);
    if (P3_SELFTEST) { if (!DESC && blockIdx.x == 0 && F.wave == 0 && lane == 0) { asm volatile("s_waitcnt vmcnt(0)" ::: "memory"); for (int c = 0; c < DM; ++c) F.out[(size_t)tA * DM + c] = diag; } }
}

struct Args { const float* in[23]; float* out; unsigned char* ws; int ph_lo, ph_hi, li, pad; };
__global__ void __launch_bounds__(NWAVES * 64, 2) mk_fwd(Args args) {
    extern __shared__ __attribute__((aligned(16))) unsigned char lds[];
    Frame F;
    F.lds = (LAS unsigned char*)lds;
    F.MISC = (volatile LAS unsigned*)(F.lds + MISC_OFF);
    F.tid = threadIdx.x; F.lane = F.tid & 63; F.wave = __builtin_amdgcn_readfirstlane(F.tid >> 6);
    F.G = gridDim.x; { const int bx = blockIdx.x; F.vcu = (F.G % 8 == 0) ? (bx % 8) * (F.G / 8) + bx / 8 : bx; }
#pragma unroll
    for (int i = 0; i < 23; ++i) F.in[i] = args.in[i];
    F.out = args.out; F.ws = args.ws; unsigned char* ws = args.ws;
    F.ctl = (gu32*)(ws + WS_CTL);
    for (int u = F.tid; u < (LDS_BYTES - LDSCTL_OFF) / 4; u += NWAVES * 64) ((LAS unsigned*)(F.lds + LDSCTL_OFF))[u] = 0u;
    __syncthreads();
#ifndef DBG_STAMP
#define DBG_STAMP (-1)
#endif
    XcdBarrier bar; bar.bar = (unsigned*)(F.ctl + CW_BAR); bar.x = 0; bar.st = nullptr;
    if (N_LAUNCHES == 1) bar = xcd_barrier_post((unsigned*)(F.ctl + CW_BAR), F.MISC + 8);
#define GRID_BAR() do { if (N_LAUNCHES == 1) { \
        if (DBG_STAMP >= 100 && F.tid == 0) { F.MISC[19] += 1u; if (DBG_STAMP == 100 || DBG_STAMP - 100 == (int)F.MISC[19]) F.MISC[16] = (unsigned)__builtin_amdgcn_s_memrealtime(); } \
        xcd_barrier(bar); \
        if (DBG_STAMP >= 100 && F.tid == 0) { if (DBG_STAMP == 100 || DBG_STAMP - 100 == (int)F.MISC[19]) F.MISC[18] += (unsigned)__builtin_amdgcn_s_memrealtime() - F.MISC[16]; } } } while (0)
    const int lo = args.ph_lo, hi = args.ph_hi;
    if (DBG_STAMP == 200 && F.tid == 0) F.MISC[16] = (unsigned)__builtin_amdgcn_s_memrealtime();
#define STAMP0(k) do { if ((k) == DBG_STAMP && F.tid == 0) F.MISC[16] = (unsigned)__builtin_amdgcn_s_memrealtime(); } while (0)
#define STAMP1(k) do { if ((k) == DBG_STAMP && F.tid == 0) F.MISC[17] = (unsigned)__builtin_amdgcn_s_memrealtime(); } while (0)
#ifndef DBG_STOP
#define DBG_STOP 99
#endif
#define IN(k) (lo <= (k) && (k) < hi && ((k) <= DBG_STOP || (k) == NPH - 1))
#ifndef DBG_REPEAT
#define DBG_REPEAT (-1)
#endif
#define REP(k) _Pragma("unroll") for (int _rep = 0; _rep < ((k) == DBG_REPEAT ? 2 : 1); ++_rep)
#define BOTH(k) (IN(k) && hi > (k) + 1)
    const int bx = (int)blockIdx.x, G = F.G;

#if defined(DBG_GEMMTEST)
    {
        p0_prologue(F); GRID_BAR();
#define GT_ONE(rep) { pg8::Gemm g{(const pg8::bf16_t*)(ws + WS_S0), (const pg8::bf16_t*)(ws + GT_W), TOK, GT_N, DM}; pg8::StaticOrder S; S.init(TOK, GT_N, G, bx); \
          pg8::EpiPlain E{(pg8::bf16_t*)(ws + (256 + 64 * (rep)) * MiB), GT_N}; pg8::gemm_phase<pg8::EpiPlain, pg8::StaticOrder, GT_ALIGN, GT_SP2, GT_F8>(F.lds + RING_OFF, g, S, E); GRID_BAR(); }
        GT_ONE(0) GT_ONE(1) GT_ONE(2) GT_ONE(3)
        { const size_t nw = (size_t)TOK * GT_N / 2, gt = (size_t)(F.vcu * NWAVES + F.wave) * 64 + F.lane, NT = (size_t)G * NWAVES * 64; unsigned cnt = 0;
          const unsigned* o0 = (const unsigned*)(ws + 256 * MiB); const unsigned* o1 = (const unsigned*)(ws + 320 * MiB); const unsigned* o2 = (const unsigned*)(ws + 384 * MiB); const unsigned* o3 = (const unsigned*)(ws + 448 * MiB);
          for (size_t i = gt; i < nw; i += NT) { const unsigned a = o0[i]; cnt += (a != o1[i]) + (a != o2[i]) + (a != o3[i]); }
          if (cnt) atomicAdd((unsigned*)(F.ctl + 2048), cnt);
          GRID_BAR();
          const float r = (float)__hip_atomic_load((unsigned*)(F.ctl + 2048), __ATOMIC_RELAXED, __HIP_MEMORY_SCOPE_AGENT);
          for (size_t i = gt; i < (size_t)TOK * DM; i += NT) F.out[i] = r; }
        return;
    }
#endif
#if defined(DBG_P1TEST)
    {
        p0_prologue(F); GRID_BAR();
#define P1T_RUN(ZUo, QKo, GABo, VTo) { pg8::Gemm g{(const pg8::bf16_t*)(ws + WS_S0), (const pg8::bf16_t*)(ws + WS_WIN), TOK, NIN, DM}; pg8::StaticOrder S; S.init(TOK, NIN, G, bx); \
          pg8::EpiIn E{(pg8::bf16_t*)(ws + (ZUo)), (pg8::bf16_t*)(ws + (ZUo) + 16 * MiB), (pg8::bf16_t*)(ws + (QKo)), (pg8::bf16_t*)(ws + (VTo)), (pg8::bf16_t*)(ws + (GABo)), 0.08838834764831845f}; \
          pg8::gemm_phase<pg8::EpiIn, pg8::StaticOrder, P1T_ALIGN, P1T_SP2>(F.lds + RING_OFF, g, S, E); GRID_BAR(); }
        P1T_RUN(WS_S1, WS_S2, WS_S4, WS_S6)
        P1T_RUN(96 * MiB, 128 * MiB, 160 * MiB, 432 * MiB)
        { const size_t gt = (size_t)(F.vcu * NWAVES + F.wave) * 64 + F.lane, NT = (size_t)G * NWAVES * 64; unsigned cnt = 0;
#define P1T_CMP(a, b, mib) { const unsigned* pa = (const unsigned*)(ws + (a)); const unsigned* pb = (const unsigned*)(ws + (b)); for (size_t i = gt; i < (size_t)(mib) * MiB / 4; i += NT) cnt += (pa[i] != pb[i]); }
          P1T_CMP(WS_S1, 96 * MiB, 32) P1T_CMP(WS_S2, 128 * MiB, 32) P1T_CMP(WS_S4, 160 * MiB, 64) P1T_CMP(WS_S6, 432 * MiB, 16)
          if (cnt) atomicAdd((unsigned*)(F.ctl + 2048), cnt);
          GRID_BAR();
          const float r = (float)__hip_atomic_load((unsigned*)(F.ctl + 2048), __ATOMIC_RELAXED, __HIP_MEMORY_SCOPE_AGENT);
          for (size_t i = gt; i < (size_t)TOK * DM; i += NT) F.out[i] = r; }
        return;
    }
#endif
    if (IN(0)) REP(0) { STAMP0(0); p0_prologue(F); STAMP1(0); if (BOTH(0)) GRID_BAR(); }

    if (IN(1)) REP(1) { STAMP0(1);
        { pg8::Gemm g{(const pg8::bf16_t*)(ws + WS_S0), (const pg8::bf16_t*)(ws + WS_WIN), TOK, 2048, DM}; pg8::SplitInOrder<false> S; S.S.init(TOK, 2048, G, bx);
          pg8::EpiIn E{(pg8::bf16_t*)(ws + WS_S1), (pg8::bf16_t*)(ws + WS_S1 + 16 * MiB), (pg8::bf16_t*)(ws + WS_S2), (pg8::bf16_t*)(ws + WS_S6), (pg8::bf16_t*)(ws + WS_S4), 0.08838834764831845f, (float*)(ws + WS_SUBK), 1.0f};
          pg8::gemm_phase<pg8::EpiIn, pg8::SplitInOrder<false>, true, true>(F.lds + RING_OFF, g, S, E); }
        { pg8::Gemm g{(const pg8::bf16_t*)(ws + WS_A0F8), (const pg8::bf16_t*)(ws + WS_WIN8), TOK, 7168, DM / 2}; pg8::SplitInOrder<true> S; S.S.init(TOK, 7168, G, bx);
          pg8::EpiIn E{(pg8::bf16_t*)(ws + WS_S1), (pg8::bf16_t*)(ws + WS_S1 + 16 * MiB), (pg8::bf16_t*)(ws + WS_S2), (pg8::bf16_t*)(ws + WS_S6), (pg8::bf16_t*)(ws + WS_S4), 0.08838834764831845f, (float*)(ws + WS_SUBK), 1.0f / (16.0f * 256.0f)};
          pg8::gemm_phase<pg8::EpiIn, pg8::SplitInOrder<true>, true, true, true>(F.lds + RING_OFF, g, S, E); }
        { pg8::Gemm g{(const pg8::bf16_t*)(ws + WS_MN8), (const pg8::bf16_t*)(ws + WS_WMKV8), MEMT, 4096, DM / 2}; pg8::ShiftedOrder S; S.init(MEMT, 4096, G, bx, G >= 160 ? 128 : 0);
          pg8::EpiKV E{(pg8::bf16_t*)(ws + WS_KM), 1.0f / (16.0f * 256.0f)};
          pg8::gemm_phase<pg8::EpiKV, pg8::ShiftedOrder, false, true, true>(F.lds + RING_OFF, g, S, E); }
        if (G == 256 && bx >= 160) peer_tables(F, (bx - 160) * NWAVES + F.wave, 96 * NWAVES, 0, TAB1);
        STAMP1(1); if (BOTH(1)) GRID_BAR();
    }

    if (IN(2)) REP(2) { STAMP0(2);
#ifndef DBG_P2DUP
#define DBG_P2DUP 0
#endif
        for (int dup = 0; dup < ((DBG_P2DUP & 1) ? 2 : 1); ++dup)
        for (int u = F.vcu; u < 256; u += G) sg_unit(F, u);
        for (int dup = 0; dup < ((DBG_P2DUP & 2) ? 2 : 1); ++dup)
        for (int u = F.vcu * 2; u < 512; u += 2 * G) { attn_unit(F, u); if (u + 1 < 512) attn_unit(F, u + 1); }
        __syncthreads();
        { pg8::Gemm g{(const pg8::bf16_t*)(ws + WS_KM), (const pg8::bf16_t*)(ws + WS_WMQ), 512, DM, 512, 4096, 2048}; pg8::PreOrder<0> S{bx, 0};
          pg8::EpiPre<true> E{(pg8::bf16_t*)(ws + WS_WKT), 2048, 1024, 0, 256, 256, 0, 32.0f};
          pg8::gemm_phase<pg8::EpiPre<true>, pg8::PreOrder<0>, false, true>(F.lds + RING_OFF, g, S, E); }
        { pg8::Gemm g{(const pg8::bf16_t*)(ws + WS_WMO), (const pg8::bf16_t*)(ws + WS_KM), DM, 512, 512, 2048, 4096}; pg8::PreOrder<1> S{bx, 64};
          pg8::EpiPre<true> E{(pg8::bf16_t*)(ws + WS_VWOT), 1024, 256, 2048, 0, 0, 256, 32.0f};
          pg8::gemm_phase<pg8::EpiPre<true>, pg8::PreOrder<1>, false, true>(F.lds + RING_OFF, g, S, E); }
        STAMP1(2); if (BOTH(2)) GRID_BAR();
    }

    if (IN(3)) REP(3) { STAMP0(3);
        { pg8::Gemm g{(const pg8::bf16_t*)(ws + WS_S3), (const pg8::bf16_t*)(ws + WS_WUPA), TOK, DM, 512}; pg8::UpOrder S; S.S.init(TOK, DM, G, bx);
          S.aoff_b = (int)((16 * MiB) / 2); S.boff_b = (int)((WS_WUPB - WS_WUPA) / 2);
          typedef pg8::EpiUp2<WS_S4, WS_S0, WS_S1> EUp; EUp E{ws, 1.0f / (64.0f * 256.0f), 1.0f / (8.0f * 256.0f)};
          pg8::gemm_phase<EUp, pg8::UpOrder, false, true, true>(F.lds + RING_OFF, g, S, E); }
        STAMP1(3); if (BOTH(3)) GRID_BAR();
    }

    if (IN(5)) REP(5) { STAMP0(5);
        pg8::Gemm g{(const pg8::bf16_t*)(ws + WS_S1), (const pg8::bf16_t*)(ws + WS_WOUT), TOK, DM, DM / 2}; pg8::StaticOrder S; S.init(TOK, DM, G, bx);
        pg8::EpiRes<true, false> E{F.in[I_X], (pg8::bf16_t*)(ws + WS_S6), (pg8::bf16_t*)(ws + WS_S0), F.in[I_GMQ], (float*)(ws + WS_PS1), 1.0f / (16.0f * 256.0f), 16.0f};
        pg8::gemm_phase<pg8::EpiRes<true, false>, pg8::StaticOrder, false, true, true>(F.lds + RING_OFF, g, S, E);
        STAMP1(5); if (BOTH(5)) GRID_BAR();
    }

    if (IN(6)) REP(6) { STAMP0(6);
        { pg8::Gemm g{(const pg8::bf16_t*)(ws + WS_S0), (const pg8::bf16_t*)(ws + WS_WKT), TOK, 1024, DM / 2}; pg8::ScoreOrder S{bx};
          pg8::EpiSoftmax E{(const float*)(ws + WS_PS1), (pg8::bf16_t*)(ws + WS_S1), 0.04419417382415922f / (16.0f * 32.0f), EPS, 256.0f};
          pg8::gemm_phase<pg8::EpiSoftmax, pg8::ScoreOrder, false, true, true>(F.lds + RING_OFF, g, S, E); }
        { constexpr int TSPLIT = TAB1 + 1024;
          if (G == 256) { if (bx < 128) peer_tables(F, bx * NWAVES + F.wave, 128 * NWAVES, TAB1, TSPLIT); else peer_tables(F, (bx - 128) * NWAVES + F.wave, 128 * NWAVES, TSPLIT, 2 * 16384); }
          else peer_tables(F, bx * NWAVES + F.wave, G * NWAVES, 0, 2 * 16384); }
        STAMP1(6); if (BOTH(6)) GRID_BAR();
    }

    if (IN(7)) REP(7) { STAMP0(7);
        pg8::Gemm g{(const pg8::bf16_t*)(ws + WS_S1), (const pg8::bf16_t*)(ws + WS_VWOT), TOK, DM, 512}; pg8::BatchOrder S; S.S.init(TOK, DM, G, bx); S.boff_b1 = 2048 * 512;
        pg8::EpiRes<false, true> E{(const void*)(ws + WS_S6), (pg8::bf16_t*)(ws + WS_S6), (pg8::bf16_t*)(ws + WS_S0), F.in[I_GFFN], (float*)(ws + WS_PS2), 1.0f / (256.0f * 32.0f), 1.0f};
        pg8::gemm_phase<pg8::EpiRes<false, true>, pg8::BatchOrder, false, true, true>(F.lds + RING_OFF, g, S, E);
        STAMP1(7); if (BOTH(7)) GRID_BAR();
    }


    if (IN(9)) REP(9) { STAMP0(9);
        pg8::Gemm g{(const pg8::bf16_t*)(ws + WS_S0), (const pg8::bf16_t*)(ws + WS_WPQ), TOK, DM, DM}; pg8::StaticOrder S; S.init(TOK, DM, G, bx);
        pg8::EpiScore E{(const float*)(ws + WS_PS2), (float*)(ws + WS_S2), EPS};
        pg8::gemm_phase<pg8::EpiScore, pg8::StaticOrder, false, true>(F.lds + RING_OFF, g, S, E);
        { pg8::Unit u; for (int i = 0; S.next(i, u); ++i) route_block(F, u.pn * 256 + u.pm * 8 + F.wave); }
        STAMP1(9); if (BOTH(9)) GRID_BAR();
    }


    if (IN(12)) REP(12) { STAMP0(12);
        const int gw = F.vcu * NWAVES + F.wave, NGW = G * NWAVES;
#if defined(DBG_PROBE)
        { const bf16* src = (const bf16*)(ws + DBG_PROBE_OFF);
          for (int t = gw; t < TOK; t += NGW) for (int c = F.lane; c < DM; c += 64) F.out[(size_t)t * DM + c] = bflo((unsigned)src[(size_t)t * DBG_PROBE_PITCH + (c % DBG_PROBE_PITCH)]); }
#elif defined(DBG_PROBE_P1)
        { const bf16* QKp = (const bf16*)(ws + WS_S2); const bf16* VTp = (const bf16*)(ws + WS_S6); const bf16* ZUp = (const bf16*)(ws + WS_S1); const bf16* ZVp = (const bf16*)(ws + WS_S1 + 16 * MiB); const bf16* GABp = (const bf16*)(ws + WS_S4);
          const bf16* KMp = (const bf16*)(ws + WS_KM);
          for (int t = gw; t < TOK; t += NGW) for (int c = F.lane; c < DM; c += 64) { float v = 0.f;
            if (DBG_PROBE_P1 & 1) v += bflo((unsigned)QKp[(size_t)t * 2048 + c]);
            if (DBG_PROBE_P1 & 2) v += bflo((unsigned)VTp[(size_t)t * 1024 + (c & 1023)]);
            if (DBG_PROBE_P1 & 4) v += bflo((unsigned)ZUp[(size_t)t * 1024 + (c & 1023)]);
            if (DBG_PROBE_P1 & 256) v += bflo((unsigned)ZVp[(size_t)t * 1024 + (c & 1023)]);
            if (DBG_PROBE_P1 & 8) v += bflo((unsigned)GABp[(size_t)t * 4096 + c]) + bflo((unsigned)GABp[(size_t)t * 4096 + 2048 + c]);
            if (DBG_PROBE_P1 & 16) v += bflo((unsigned)KMp[(size_t)(t & 1023) * 2048 + c]);
            if (DBG_PROBE_P1 & 32) v += bflo((unsigned)((const bf16*)(ws + WS_S0))[(size_t)t * 2048 + c]);
            if (DBG_PROBE_P1 & 64) v += bflo((unsigned)((const bf16*)(ws + WS_WIN))[(size_t)t * 2048 + c]);
            if (DBG_PROBE_P1 & 128) v += bflo((unsigned)((const bf16*)(ws + WS_MN))[(size_t)(t & 511) * 2048 + c]) + bflo((unsigned)((const bf16*)(ws + WS_WMKV))[(size_t)(t & 4095) * 2048 + c]);
            F.out[(size_t)t * DM + c] = v; } }
#else
        __syncthreads();
        if (gw + NGW < TOK) peer_pair3<false>(F, gw, gw + NGW);
        if (gw + 3 * NGW < TOK) peer_pair3<true>(F, gw + 2 * NGW, gw + 3 * NGW);
#endif
        if (DBG_REPEAT == NPH - 1) GRID_BAR();
        STAMP1(12);
    }
#undef IN
#undef BOTH
    if (DBG_STAMP == 200) { GRID_BAR(); if (F.tid == 0) F.MISC[17] = (unsigned)__builtin_amdgcn_s_memrealtime(); }
    if (DBG_STAMP >= 0) { __syncthreads(); if (blockIdx.x == 0 && threadIdx.x == 0) { asm volatile("s_waitcnt vmcnt(0)" ::: "memory"); args.out[0] = (DBG_STAMP == 200 ? (float)(F.MISC[17] - F.MISC[16]) * 0.000625f : (DBG_STAMP >= 100 ? (float)F.MISC[18] : (float)(F.MISC[17] - F.MISC[16])) * 0.005f); } }
}

extern "C" void kernel_launch(void* const* d_in, const int* in_sizes, int n_in, void* d_out, int out_size, void* d_ws, size_t ws_size, hipStream_t stream) {
    static int grid = 0;
    if (grid == 0) {
        if (n_in != 23 || out_size != TOK * DM || ws_size < WS_END) { fprintf(stderr, "kernel_launch: unexpected shapes (n_in %d, out %d, ws %zu)\n", n_in, out_size, ws_size); grid = -1; return; }
        int dev = 0, cus = 0, per_cu = 0;
        if (hipGetDevice(&dev) != hipSuccess || hipDeviceGetAttribute(&cus, hipDeviceAttributeMultiprocessorCount, dev) != hipSuccess) { grid = -1; return; }
        if (hipFuncSetAttribute((const void*)mk_fwd, hipFuncAttributeMaxDynamicSharedMemorySize, LDS_BYTES) != hipSuccess) { fprintf(stderr, "kernel_launch: hipFuncSetAttribute failed\n"); grid = -1; return; }
        if (hipOccupancyMaxActiveBlocksPerMultiprocessor(&per_cu, (const void*)mk_fwd, NWAVES * 64, LDS_BYTES) != hipSuccess || per_cu < 1) { fprintf(stderr, "kernel_launch: occupancy query reports %d blocks per CU\n", per_cu); }
        (void)hipGetLastError();
        grid = cus;
    }
    if (grid < 0) return;
    if (hipMemsetAsync((char*)d_ws + WS_CTL, 0, CTL_ZERO_BYTES, stream) != hipSuccess) return;
    Args a{};
    for (int i = 0; i < 23; ++i) a.in[i] = (const float*)d_in[i];
    a.out = (float*)d_out; a.ws = (unsigned char*)d_ws; a.pad = 0;
    for (int li = 0; li < N_LAUNCHES; ++li) {
        a.ph_lo = (N_LAUNCHES == 1) ? 0 : li; a.ph_hi = (N_LAUNCHES == 1) ? NPH : li + 1; a.li = li;
        hipLaunchKernelGGL(mk_fwd, dim3(grid), dim3(NWAVES * 64), LDS_BYTES, stream, a);
        if (hipPeekAtLastError() != hipSuccess) { fprintf(stderr, "kernel_launch: launch %d failed\n", li); break; }
    }
}
```

```cpp
#include <hip/hip_runtime.h>
#include <cstdio>
#include <cstdint>
#define MK_N_LAUNCHES 1
namespace pg8 {
#define PG8_LAS __attribute__((address_space(3)))
typedef unsigned short bf16_t;
typedef short bf16x8 __attribute__((ext_vector_type(8)));
typedef float f32x4 __attribute__((ext_vector_type(4)));
typedef unsigned u32x4 __attribute__((ext_vector_type(4)));
constexpr int BM = 256, BK = 64, HALF = 128, HTB = HALF * BK * 2  , STAGE_BYTES = 8 * HTB, NXCD = 8, WGM = 8;

__host__ __device__ __forceinline__ int lds_byte(int r, int c) { const int st = (r >> 4) * 2 + (c >> 5), rr = r & 15, cc = c & 31, ob = rr * 64 + cc * 2; return st * 1024 + (ob ^ (((ob >> 9) & 1) << 5)); }
__host__ __device__ __forceinline__ void stage_rc(int b, int& R, int& C) { const int st = b / 1024, sb = b % 1024, swz = sb ^ (((sb >> 9) & 1) << 5); R = (st >> 1) * 16 + swz / 64; C = (st & 1) * 32 + (swz % 64) / 2; }
__host__ __device__ __forceinline__ int perm32(int rho) { const int n = rho >> 4, i = rho & 15; return 8 * (i >> 2) + 4 * n + (i & 3); }

struct Unit { int pm, pn; int aoff = 0, boff = 0, aux = 0; };
struct Gemm { const bf16_t* A; const bf16_t* Bt; int M, N, K; int lda = 0, ldb = 0; };

struct StaticOrder {
    int nM, nN, nwg, G, c;
    __host__ __device__ void init(int M, int N, int G_, int c_) { nM = M / BM; nN = N / BM; nwg = nM * nN; G = G_; c = c_; }
    __host__ __device__ bool next(int i, Unit& u) const {
        const long L = (long)i * G + c; if (L >= nwg) return false;
        int wgid = (int)L; { const int q = nwg / NXCD, r = nwg % NXCD, xcd = wgid % NXCD, off = wgid / NXCD; wgid = (xcd < r ? xcd * (q + 1) : r * (q + 1) + (xcd - r) * q) + off; }
        const int nig = WGM * nN, gid = wgid / nig, fm = gid * WGM, gsz = (nM - fm) < WGM ? (nM - fm) : WGM;
        u.pm = fm + ((wgid % nig) % gsz); u.pn = (wgid % nig) / gsz; return true;
    }
    __device__ __forceinline__ void a_ready(const Unit&) const {}
    __device__ __forceinline__ void done(const Unit&) const {}
};

typedef __bf16 bf16x2_cv __attribute__((ext_vector_type(2)));
typedef float f32x2_cv __attribute__((ext_vector_type(2)));
__device__ __forceinline__ unsigned cvt_pk_bf16(float lo, float hi) { const f32x2_cv v = {lo, hi}; const bf16x2_cv b = __builtin_convertvector(v, bf16x2_cv); return __builtin_bit_cast(unsigned, b); }
typedef float f32x2 __attribute__((ext_vector_type(2)));
__device__ __forceinline__ f32x2 gelu_pk(f32x2 v) {
    const f32x2 av = __builtin_elementwise_abs(v), d = av * 0.2316418882f + 1.0f;
    f32x2 t; t.x = __builtin_amdgcn_rcpf(d.x); t.y = __builtin_amdgcn_rcpf(d.y);
    f32x2 q = t * 0.5307027145f + (-0.7265760135f); q = q * t + 0.7107068705f; q = q * t + (-0.142248368f); q = q * t + 0.127414796f; q = q * t;
    const f32x2 s = (v * v) * (-0.72134752044f);
    f32x2 e; e.x = __builtin_amdgcn_exp2f(s.x); e.y = __builtin_amdgcn_exp2f(s.y);
    const f32x2 m = v * (q * e), r = v - m;
    f32x2 o; o.x = v.x < 0.f ? m.x : r.x; o.y = v.y < 0.f ? m.y : r.y; return o;
}
__device__ __forceinline__ float sigmoid1(float x) { return __builtin_amdgcn_rcpf(1.0f + __expf(-x)); }
__device__ __forceinline__ u32x4 pack8(const f32x4& v0, const f32x4& v1) { u32x4 w; w.x = cvt_pk_bf16(v0[0], v0[1]); w.y = cvt_pk_bf16(v0[2], v0[3]); w.z = cvt_pk_bf16(v1[0], v1[1]); w.w = cvt_pk_bf16(v1[2], v1[3]); return w; }
__device__ __forceinline__ float bf_lo(unsigned w) { return __builtin_bit_cast(float, w << 16); }
__device__ __forceinline__ float bf_hi(unsigned w) { return __builtin_bit_cast(float, w & 0xffff0000u); }
__device__ __forceinline__ void unpack8(const u32x4& w, f32x4& v0, f32x4& v1) { v0 = (f32x4){bf_lo(w.x), bf_hi(w.x), bf_lo(w.y), bf_hi(w.y)}; v1 = (f32x4){bf_lo(w.z), bf_hi(w.z), bf_lo(w.w), bf_hi(w.w)}; }

#ifndef DBG_NO_T1
#define DBG_NO_T1 0
#endif
#define PG8_THROTTLE() asm volatile("s_waitcnt vmcnt(24)" ::: "memory")
typedef unsigned u32x2e __attribute__((ext_vector_type(2)));
__device__ __forceinline__ u32x2e pack8_fp8(const f32x4& v0, const f32x4& v1) { int a = 0, b = 0;
    a = __builtin_amdgcn_cvt_pk_fp8_f32(v0[0], v0[1], a, false); a = __builtin_amdgcn_cvt_pk_fp8_f32(v0[2], v0[3], a, true);
    b = __builtin_amdgcn_cvt_pk_fp8_f32(v1[0], v1[1], b, false); b = __builtin_amdgcn_cvt_pk_fp8_f32(v1[2], v1[3], b, true); return (u32x2e){(unsigned)a, (unsigned)b}; }
#define PG8_EPI_LOOP(...) \
    _Pragma("unroll") for (int ai = 0; ai < 2; ++ai) _Pragma("unroll") for (int m = 0; m < 4; ++m) { \
        const int row = u.pm * BM + ai * HALF + wr * 64 + m * 16 + fr; (void)row; \
        _Pragma("unroll") for (int bj = 0; bj < 2; ++bj) { \
            const int col = u.pn * BM + bj * HALF + wc * 32 + 8 * fq; (void)col; \
            f32x4 v0 = acc[ai][bj][m][0], v1 = acc[ai][bj][m][1]; __VA_ARGS__ } }

struct EpiIn {
    static constexpr bool PERM = true, AFTER_DRAIN = false, MIDHOOK = false;
    bf16_t* ZU;
    bf16_t* ZVT;
    bf16_t* QK;
    bf16_t* VT;
    bf16_t* GAB;
    float qscale;
    float* PSV;
    float s8;
    __device__ __forceinline__ void operator()(const f32x4 (&acc)[2][2][4][2], const Unit& u, int wr, int wc, int fr, int fq) const {
        const int pn = u.pn;
        if (pn < 4) {
            PG8_EPI_LOOP({ f32x2 a = gelu_pk((f32x2){v0[0], v0[1]}), b = gelu_pk((f32x2){v0[2], v0[3]}), c = gelu_pk((f32x2){v1[0], v1[1]}), d = gelu_pk((f32x2){v1[2], v1[3]});
                v0 = (f32x4){a.x, a.y, b.x, b.y}; v1 = (f32x4){c.x, c.y, d.x, d.y};
                *(u32x4*)(ZU + (size_t)row * 1024 + col) = pack8(v0, v1); })
        } else if (pn < 8) {
#pragma unroll
            for (int ai = 0; ai < 2; ++ai)
#pragma unroll
                for (int m = 0; m < 4; ++m) { const int row = u.pm * BM + ai * HALF + wr * 64 + m * 16 + fr; float s = 0.f, q = 0.f;
#pragma unroll
                    for (int bj = 0; bj < 2; ++bj) { const int col = u.pn * BM + bj * HALF + wc * 32 + 8 * fq; const f32x4 v0 = acc[ai][bj][m][0], v1 = acc[ai][bj][m][1];
                        f32x2 a = gelu_pk((f32x2){v0[0], v0[1]}), b = gelu_pk((f32x2){v0[2], v0[3]}), cc = gelu_pk((f32x2){v1[0], v1[1]}), d = gelu_pk((f32x2){v1[2], v1[3]});
                        const u32x4 w = pack8((f32x4){a.x, a.y, b.x, b.y}, (f32x4){cc.x, cc.y, d.x, d.y});
                        const unsigned w4[4] = {w.x, w.y, w.z, w.w};
#pragma unroll
                        for (int e = 0; e < 4; ++e) { const float x0 = bf_lo(w4[e]), x1 = bf_hi(w4[e]); s += x0 + x1; q += x0 * x0 + x1 * x1; }
                        bf16_t* p = ZVT + ((size_t)(row >> 7) * 1024 + (col - 1024)) * 128 + (row & 127);
                        p[0 * 128] = (bf16_t)(w.x & 0xffffu); p[1 * 128] = (bf16_t)(w.x >> 16); p[2 * 128] = (bf16_t)(w.y & 0xffffu); p[3 * 128] = (bf16_t)(w.y >> 16);
                        p[4 * 128] = (bf16_t)(w.z & 0xffffu); p[5 * 128] = (bf16_t)(w.z >> 16); p[6 * 128] = (bf16_t)(w.w & 0xffffu); p[7 * 128] = (bf16_t)(w.w >> 16); PG8_THROTTLE(); }
                    s += __shfl_xor(s, 16); s += __shfl_xor(s, 32); q += __shfl_xor(q, 16); q += __shfl_xor(q, 32);
                    if (fq == 0) { float* ps = PSV + ((size_t)row * 16 + (pn - 4) * 4 + wc) * 2; ps[0] = s; ps[1] = q; } }
        } else if (pn < 16) {
            const float sc = (pn < 12 ? qscale : 1.0f) * s8;
            PG8_EPI_LOOP({ v0 = v0 * sc; v1 = v1 * sc; *(u32x4*)(QK + (size_t)row * 2048 + (col - 2048)) = pack8(v0, v1); })
        } else if (pn < 20) {
            PG8_EPI_LOOP({ const u32x4 w = pack8(v0 * s8, v1 * s8); const int c = col - 4096;
                bf16_t* p = VT + ((size_t)((row >> 12) * 1024 + c)) * 4096 + (row & 4095);
                p[0 * 4096] = (bf16_t)(w.x & 0xffffu); p[1 * 4096] = (bf16_t)(w.x >> 16); p[2 * 4096] = (bf16_t)(w.y & 0xffffu); p[3 * 4096] = (bf16_t)(w.y >> 16);
                p[4 * 4096] = (bf16_t)(w.z & 0xffffu); p[5 * 4096] = (bf16_t)(w.z >> 16); p[6 * 4096] = (bf16_t)(w.w & 0xffffu); p[7 * 4096] = (bf16_t)(w.w >> 16); PG8_THROTTLE(); })
        } else {
            PG8_EPI_LOOP({ v0 = v0 * s8; v1 = v1 * s8; v0 = (f32x4){sigmoid1(v0[0]), sigmoid1(v0[1]), sigmoid1(v0[2]), sigmoid1(v0[3])}; v1 = (f32x4){sigmoid1(v1[0]), sigmoid1(v1[1]), sigmoid1(v1[2]), sigmoid1(v1[3])};
                unsigned ga, gb;
                ga = (unsigned)(v0[0] * 255.0f + 0.5f) | ((unsigned)(v0[1] * 255.0f + 0.5f) << 8) | ((unsigned)(v0[2] * 255.0f + 0.5f) << 16) | ((unsigned)(v0[3] * 255.0f + 0.5f) << 24);
                gb = (unsigned)(v1[0] * 255.0f + 0.5f) | ((unsigned)(v1[1] * 255.0f + 0.5f) << 8) | ((unsigned)(v1[2] * 255.0f + 0.5f) << 16) | ((unsigned)(v1[3] * 255.0f + 0.5f) << 24);
                *(u32x2e*)((unsigned char*)GAB + (size_t)row * 4096 + (col - 5120)) = (u32x2e){ga, gb}; })
        }
    }
};
struct EpiKV {
    static constexpr bool PERM = true, AFTER_DRAIN = false, MIDHOOK = false;
    bf16_t* KVM; float s8;
    __device__ __forceinline__ void operator()(const f32x4 (&acc)[2][2][4][2], const Unit& u, int wr, int wc, int fr, int fq) const {
        PG8_EPI_LOOP({ *(u32x4*)(KVM + (size_t)row * 4096 + col) = pack8(v0 * s8, v1 * s8); })
    }
};
template <bool O8> struct EpiPre {
    static constexpr bool PERM = true, AFTER_DRAIN = false, MIDHOOK = false;
    bf16_t* O; int ldc, rs_pm, rs_pn, rs_aux, cs_pn, cs_aux; float oscale;
    __device__ __forceinline__ void operator()(const f32x4 (&acc)[2][2][4][2], const Unit& u, int wr, int wc, int fr, int fq) const {
        const int r0 = u.pm * rs_pm + u.pn * rs_pn + u.aux * rs_aux, c0 = u.pn * cs_pn + u.aux * cs_aux;
#pragma unroll
        for (int ai = 0; ai < 2; ++ai)
#pragma unroll
            for (int m = 0; m < 4; ++m)
#pragma unroll
                for (int bj = 0; bj < 2; ++bj) { const int r = r0 + ai * HALF + wr * 64 + m * 16 + fr, cc = c0 + bj * HALF + wc * 32 + 8 * fq;
                    if (O8) *(u32x2e*)((unsigned char*)O + (size_t)r * ldc + cc) = pack8_fp8(acc[ai][bj][m][0] * oscale, acc[ai][bj][m][1] * oscale);
                    else *(u32x4*)(O + (size_t)r * ldc + cc) = pack8(acc[ai][bj][m][0], acc[ai][bj][m][1]); }
    }
};
struct EpiSoftmax {
    static constexpr bool PERM = true, AFTER_DRAIN = true, MIDHOOK = false;
    const float* PS; bf16_t* P; float scale, eps, pscale;
    __device__ __forceinline__ void operator()(const f32x4 (&)[2][2][4][2], const Unit&, int, int, int, int) const {}
    __device__ __forceinline__ void fused(f32x4 (&acc)[2][2][4][2], const Unit& u, int wr, int wc, int fr, int fq, PG8_LAS unsigned char* lds, int wid, int lane) const {
        PG8_LAS float* RMX = (PG8_LAS float*)lds;
        PG8_LAS float* RSM = (PG8_LAS float*)(lds + 4096);
        float mx[2][4];
#pragma unroll
        for (int aim = 0; aim < 4; ++aim) { const int ai = aim >> 1, m0 = (aim & 1) * 2;
            f32x4 t[2][2];
#pragma unroll
            for (int mm = 0; mm < 2; ++mm) { const f32x4* ps = (const f32x4*)(PS + (size_t)(u.pm * BM + ai * HALF + wr * 64 + (m0 + mm) * 16 + fr) * 32);
#pragma unroll
                for (int i = 0; i < 2; ++i) t[mm][i] = ps[2 * fq + i]; }
            asm volatile("" ::: "memory");
#pragma unroll
            for (int mm = 0; mm < 2; ++mm) { const int m = m0 + mm; float s = 0.f;
#pragma unroll
                for (int i = 0; i < 2; ++i) s += (t[mm][i][0] + t[mm][i][1]) + (t[mm][i][2] + t[mm][i][3]);
                s += __shfl_xor(s, 16); s += __shfl_xor(s, 32);
                const float rs = __builtin_amdgcn_rsqf(s * (1.0f / 2048.0f) + eps) * scale; float x = -1e30f;
#pragma unroll
                for (int bj = 0; bj < 2; ++bj)
#pragma unroll
                    for (int n = 0; n < 2; ++n) { acc[ai][bj][m][n] = acc[ai][bj][m][n] * rs; const f32x4 v = acc[ai][bj][m][n]; x = fmaxf(x, fmaxf(fmaxf(v[0], v[1]), fmaxf(v[2], v[3]))); }
                x = fmaxf(x, __shfl_xor(x, 16)); x = fmaxf(x, __shfl_xor(x, 32));
                if (fq == 0) RMX[(ai * HALF + wr * 64 + m * 16 + fr) * 4 + wc] = x;
                mx[ai][m] = x; }
        }
        asm volatile("s_waitcnt lgkmcnt(0)" ::: "memory"); __builtin_amdgcn_s_barrier(); asm volatile("" ::: "memory");
#pragma unroll
        for (int ai = 0; ai < 2; ++ai)
#pragma unroll
            for (int m = 0; m < 4; ++m) { const int r = ai * HALF + wr * 64 + m * 16 + fr; const f32x4 q = *(const PG8_LAS f32x4*)(RMX + r * 4);
                const float mxr = fmaxf(fmaxf(q[0], q[1]), fmaxf(q[2], q[3])); float sm = 0.f;
#pragma unroll
                for (int bj = 0; bj < 2; ++bj)
#pragma unroll
                    for (int n = 0; n < 2; ++n) { f32x4 v = acc[ai][bj][m][n]; v = (f32x4){__expf(v[0] - mxr), __expf(v[1] - mxr), __expf(v[2] - mxr), __expf(v[3] - mxr)}; acc[ai][bj][m][n] = v; sm += (v[0] + v[1]) + (v[2] + v[3]); }
                sm += __shfl_xor(sm, 16); sm += __shfl_xor(sm, 32);
                if (fq == 0) RSM[r * 4 + wc] = sm; }
        asm volatile("s_waitcnt lgkmcnt(0)" ::: "memory"); __builtin_amdgcn_s_barrier(); asm volatile("" ::: "memory");
#pragma unroll
        for (int ai = 0; ai < 2; ++ai)
#pragma unroll
            for (int m = 0; m < 4; ++m) { const int r = ai * HALF + wr * 64 + m * 16 + fr; const f32x4 q = *(const PG8_LAS f32x4*)(RSM + r * 4);
                const float inv = __builtin_amdgcn_rcpf((q[0] + q[1]) + (q[2] + q[3])) * pscale;
#pragma unroll
                for (int bj = 0; bj < 2; ++bj) *(u32x2e*)((unsigned char*)P + (size_t)(u.pm * BM + r) * 1024 + u.pn * BM + bj * HALF + wc * 32 + 8 * fq) = pack8_fp8(acc[ai][bj][m][0] * inv, acc[ai][bj][m][1] * inv); }
    }
};
template <size_t GAB_OFF, size_t T1_OFF, size_t MRG_OFF> struct EpiUp2 {
    static constexpr bool PERM = true, AFTER_DRAIN = false, MIDHOOK = false, CHAIN = true;
    unsigned char* wsb; float bscale, ascale;
    __device__ __forceinline__ void operator()(const f32x4 (&acc_)[2][2][4][2], const Unit& u, int wr, int wc, int fr, int fq) const {
        f32x4 (&acc)[2][2][4][2] = const_cast<f32x4 (&)[2][2][4][2]>(acc_);
        const bf16_t* GAB = (const bf16_t*)(wsb + GAB_OFF); bf16_t* MRG = (bf16_t*)(wsb + MRG_OFF);
        const bool second = u.aux != 0;
#pragma unroll
        for (int ai = 0; ai < 2; ++ai) {
            u32x2e ga[4][2], gb[4][2];
#pragma unroll
            for (int m = 0; m < 4; ++m)
#pragma unroll
                for (int bj = 0; bj < 2; ++bj) { const int row = u.pm * BM + ai * HALF + wr * 64 + m * 16 + fr, col = u.pn * BM + bj * HALF + wc * 32 + 8 * fq;
                    gb[m][bj] = *(const u32x2e*)((const unsigned char*)GAB + (size_t)row * 4096 + 2048 + col);
                    ga[m][bj] = second ? (u32x2e){0u, 0u} : *(const u32x2e*)((const unsigned char*)GAB + (size_t)row * 4096 + col); }
            asm volatile("" ::: "memory");
#pragma unroll
            for (int m = 0; m < 4; ++m)
#pragma unroll
                for (int bj = 0; bj < 2; ++bj) { const int row = u.pm * BM + ai * HALF + wr * 64 + m * 16 + fr, col = u.pn * BM + bj * HALF + wc * 32 + 8 * fq;
                    const unsigned gbx = gb[m][bj].x, gby = gb[m][bj].y;
                    f32x4 b0 = (f32x4){(float)(gbx & 255u), (float)((gbx >> 8) & 255u), (float)((gbx >> 16) & 255u), (float)(gbx >> 24)}, b1 = (f32x4){(float)(gby & 255u), (float)((gby >> 8) & 255u), (float)((gby >> 16) & 255u), (float)(gby >> 24)};
#pragma unroll
                    for (int e = 0; e < 4; ++e) { b0[e] = fmaxf(b0[e] * (1.0f / 255.0f), 1e-6f) * bscale; b1[e] = fmaxf(b1[e] * (1.0f / 255.0f), 1e-6f) * bscale; }
                    if (second) *(u32x2e*)((unsigned char*)MRG + (size_t)row * 2048 + col) = pack8_fp8(acc[ai][bj][m][0] * b0 * 16.0f, acc[ai][bj][m][1] * b1 * 16.0f);
                    else { const unsigned gax = ga[m][bj].x, gay = ga[m][bj].y;
                        const f32x4 a0 = (f32x4){(float)(gax & 255u), (float)((gax >> 8) & 255u), (float)((gax >> 16) & 255u), (float)(gax >> 24)} * (1.0f / 255.0f), a1 = (f32x4){(float)(gay & 255u), (float)((gay >> 8) & 255u), (float)((gay >> 16) & 255u), (float)(gay >> 24)} * (1.0f / 255.0f);
#pragma unroll
                        for (int e = 0; e < 4; ++e) { acc[ai][bj][m][0][e] *= a0[e] * ascale * __builtin_amdgcn_rcpf(b0[e]); acc[ai][bj][m][1][e] *= a1[e] * ascale * __builtin_amdgcn_rcpf(b1[e]); } } }
            asm volatile("" ::: "memory");
        }
    }
};
template <bool AN8, bool BASE16, bool NOH = false> struct EpiRes {
    static constexpr bool PERM = true, AFTER_DRAIN = false, MIDHOOK = false;
    const void* base; bf16_t* H; bf16_t* AN; const float* gain; float* PS; float accscale, an_scale;
    __device__ __forceinline__ void operator()(const f32x4 (&acc)[2][2][4][2], const Unit& u, int wr, int wc, int fr, int fq) const {
        f32x4 g[2][2];
#pragma unroll
        for (int bj = 0; bj < 2; ++bj) { const int col = u.pn * BM + bj * HALF + wc * 32 + 8 * fq; g[bj][0] = *(const f32x4*)(gain + col); g[bj][1] = *(const f32x4*)(gain + col + 4); }
#pragma unroll
        for (int aim = 0; aim < 4; ++aim) { const int ai = aim >> 1, m0 = (aim & 1) * 2;
            f32x4 b[2][2][2];
#pragma unroll
            for (int mm = 0; mm < 2; ++mm)
#pragma unroll
                for (int bj = 0; bj < 2; ++bj) { const size_t off = (size_t)(u.pm * BM + ai * HALF + wr * 64 + (m0 + mm) * 16 + fr) * 2048 + u.pn * BM + bj * HALF + wc * 32 + 8 * fq;
                    if (BASE16) { unpack8(*(const u32x4*)((const bf16_t*)base + off), b[mm][bj][0], b[mm][bj][1]); }
                    else { b[mm][bj][0] = __builtin_nontemporal_load((const f32x4*)((const float*)base + off)); b[mm][bj][1] = __builtin_nontemporal_load((const f32x4*)((const float*)base + off + 4)); } }
            asm volatile("" ::: "memory");
#pragma unroll
            for (int mm = 0; mm < 2; ++mm) { const int m = m0 + mm;
                const int row = u.pm * BM + ai * HALF + wr * 64 + m * 16 + fr; float ss = 0.f;
#pragma unroll
                for (int bj = 0; bj < 2; ++bj) { const int col = u.pn * BM + bj * HALF + wc * 32 + 8 * fq; const size_t off = (size_t)row * 2048 + col;
                    const f32x4 h0 = acc[ai][bj][m][0] * accscale + b[mm][bj][0], h1 = acc[ai][bj][m][1] * accscale + b[mm][bj][1];
                    if (!NOH) *(u32x4*)(H + off) = pack8(h0, h1);
                    ss += (h0[0] * h0[0] + h0[1] * h0[1]) + (h0[2] * h0[2] + h0[3] * h0[3]) + (h1[0] * h1[0] + h1[1] * h1[1]) + (h1[2] * h1[2] + h1[3] * h1[3]);
                    if (AN8) *(u32x2e*)((unsigned char*)AN + off) = pack8_fp8(h0 * g[bj][0] * an_scale, h1 * g[bj][1] * an_scale);
                    else *(u32x4*)(AN + off) = pack8(h0 * g[bj][0], h1 * g[bj][1]); }
                ss += __shfl_xor(ss, 16); ss += __shfl_xor(ss, 32);
                if (fq == 0) PS[(size_t)row * 32 + u.pn * 4 + wc] = ss;
            }
            asm volatile("" ::: "memory");
        }
    }
};
struct EpiRowScale {
    static constexpr bool PERM = true, AFTER_DRAIN = false, MIDHOOK = false;
    const float* PS; bf16_t* O; float scale, eps;
    __device__ __forceinline__ void operator()(const f32x4 (&acc)[2][2][4][2], const Unit& u, int wr, int wc, int fr, int fq) const {
#pragma unroll
        for (int aim = 0; aim < 4; ++aim) { const int ai = aim >> 1, m0 = (aim & 1) * 2;
            f32x4 t[2][2];
#pragma unroll
            for (int mm = 0; mm < 2; ++mm) { const f32x4* ps = (const f32x4*)(PS + (size_t)(u.pm * BM + ai * HALF + wr * 64 + (m0 + mm) * 16 + fr) * 32);
#pragma unroll
                for (int i = 0; i < 2; ++i) t[mm][i] = ps[2 * fq + i]; }
            asm volatile("" ::: "memory");
#pragma unroll
            for (int mm = 0; mm < 2; ++mm) { const int m = m0 + mm;
                const int row = u.pm * BM + ai * HALF + wr * 64 + m * 16 + fr; float s = 0.f;
#pragma unroll
                for (int i = 0; i < 2; ++i) s += (t[mm][i][0] + t[mm][i][1]) + (t[mm][i][2] + t[mm][i][3]);
                s += __shfl_xor(s, 16); s += __shfl_xor(s, 32);
                const float rs = __builtin_amdgcn_rsqf(s * (1.0f / 2048.0f) + eps) * scale;
#pragma unroll
                for (int bj = 0; bj < 2; ++bj) { const int col = u.pn * BM + bj * HALF + wc * 32 + 8 * fq;
                    *(u32x4*)(O + (size_t)row * 2048 + col) = pack8(acc[ai][bj][m][0] * rs, acc[ai][bj][m][1] * rs); }
            }
        }
    }
};
struct EpiScore {
    static constexpr bool PERM = true, AFTER_DRAIN = false, MIDHOOK = false;
    const float* PS; float* SCT; float eps;
    __device__ __forceinline__ void operator()(const f32x4 (&acc)[2][2][4][2], const Unit& u, int wr, int wc, int fr, int fq) const {
#pragma unroll
        for (int aim = 0; aim < 4; ++aim) { const int ai = aim >> 1, m0 = (aim & 1) * 2;
            f32x4 t[2][2];
#pragma unroll
            for (int mm = 0; mm < 2; ++mm) { const f32x4* ps = (const f32x4*)(PS + (size_t)(u.pm * BM + ai * HALF + wr * 64 + (m0 + mm) * 16 + fr) * 32);
#pragma unroll
                for (int i = 0; i < 2; ++i) t[mm][i] = ps[2 * fq + i]; }
            asm volatile("" ::: "memory");
#pragma unroll
            for (int mm = 0; mm < 2; ++mm) { const int m = m0 + mm;
                const int row = u.pm * BM + ai * HALF + wr * 64 + m * 16 + fr; float s = 0.f;
#pragma unroll
                for (int i = 0; i < 2; ++i) s += (t[mm][i][0] + t[mm][i][1]) + (t[mm][i][2] + t[mm][i][3]);
                s += __shfl_xor(s, 16); s += __shfl_xor(s, 32);
                const float rs = __builtin_amdgcn_rsqf(s * (1.0f / 2048.0f) + eps);
#pragma unroll
                for (int bj = 0; bj < 2; ++bj) { const int key0 = wc * 32 + 8 * fq;
                    typedef __fp16 h2_ __attribute__((ext_vector_type(2)));
                    const f32x4 s0 = acc[ai][bj][m][0] * rs, s1 = acc[ai][bj][m][1] * rs;
                    const h2_ p0 = __builtin_amdgcn_cvt_pkrtz(s0[0], s0[1]), p1 = __builtin_amdgcn_cvt_pkrtz(s0[2], s0[3]), p2 = __builtin_amdgcn_cvt_pkrtz(s1[0], s1[1]), p3 = __builtin_amdgcn_cvt_pkrtz(s1[2], s1[3]);
                    unsigned char* dst = (unsigned char*)SCT + ((size_t)(key0 >> 3) * (8192 * 16) + (size_t)(u.pn * 2 + bj) * 8192 + row) * 16;
                    *(u32x4*)dst = (u32x4){__builtin_bit_cast(unsigned, p0), __builtin_bit_cast(unsigned, p1), __builtin_bit_cast(unsigned, p2), __builtin_bit_cast(unsigned, p3)}; }
            }
        }
    }
};
struct EpiPlain {
    static constexpr bool PERM = true, AFTER_DRAIN = false, MIDHOOK = false;
    bf16_t* O; int ldc;
    __device__ __forceinline__ void operator()(const f32x4 (&acc)[2][2][4][2], const Unit& u, int wr, int wc, int fr, int fq) const {
        PG8_EPI_LOOP({ *(u32x4*)(O + (size_t)row * ldc + col) = pack8(v0, v1); })
    }
};
template <int WHICH> struct PreOrder {
    int c, lo;
    __host__ __device__ bool next(int i, Unit& u) const { const int idx = c - lo; if (i != 0 || idx < 0 || idx >= 64) return false;
        const int bh = idx >> 3, t = idx & 7, b = bh >> 2, h = bh & 3; u.aux = h;
        if (WHICH == 0) { u.pm = b; u.pn = t; u.aoff = h * 512; u.boff = h * 512; } else { u.pm = t; u.pn = b; u.aoff = h * 512; u.boff = 2048 + h * 512; }
        return true; }
    __device__ __forceinline__ void a_ready(const Unit&) const {}
    __device__ __forceinline__ void done(const Unit&) const {}
};
struct ScoreOrder {
    int c;
    __host__ __device__ bool next(int i, Unit& u) const { if (i != 0 || c >= 128) return false; const int idx = (c & 7) * 16 + (c >> 3); u.pm = idx >> 2; u.pn = idx & 3; u.aoff = 0; u.boff = u.pm >= 16 ? 1024 * 1024 : 0; return true; }
    __device__ __forceinline__ void a_ready(const Unit&) const {}
    __device__ __forceinline__ void done(const Unit&) const {}
};
struct BatchOrder {
    StaticOrder S; int boff_b1;
    __host__ __device__ bool next(int i, Unit& u) const { if (!S.next(i, u)) return false; u.aoff = 0; u.boff = u.pm >= 16 ? boff_b1 : 0; return true; }
    __device__ __forceinline__ void a_ready(const Unit&) const {}
    __device__ __forceinline__ void done(const Unit&) const {}
};
struct UpOrder {
    StaticOrder S; int aoff_b, boff_b;
    __host__ __device__ bool next(int i, Unit& u) const { if (!S.next(i >> 1, u)) return false; u.aux = i & 1; u.aoff = (i & 1) ? aoff_b : 0; u.boff = (i & 1) ? boff_b : 0; return true; }
    __device__ __forceinline__ void a_ready(const Unit&) const {}
    __device__ __forceinline__ void done(const Unit&) const {}
};
template <bool F8PART> struct SplitInOrder {
    StaticOrder S;
    __host__ __device__ bool next(int i, Unit& u) const { if (!S.next(i, u)) return false; u.aoff = 0;
        if (F8PART) { u.pn += 8; u.boff = -8 * 256 * 1024; } else { u.boff = 0; } return true; }
    __device__ __forceinline__ void a_ready(const Unit&) const {}
    __device__ __forceinline__ void done(const Unit&) const {}
};
struct ShiftedOrder {
    StaticOrder S; bool on;
    __host__ __device__ void init(int M, int N, int G_, int c_, int first) { on = c_ >= first; S.init(M, N, G_, on ? c_ - first : 0); }
    __host__ __device__ bool next(int i, Unit& u) const { return on && S.next(i, u); }
    __device__ __forceinline__ void a_ready(const Unit&) const {}
    __device__ __forceinline__ void done(const Unit&) const {}
};

template <class E, class = void> struct EpiChain { static constexpr bool value = false; };
template <class E> struct EpiChain<E, decltype((void)E::CHAIN)> { static constexpr bool value = E::CHAIN; };
template <class Epi, class Sched, bool ALIGN_EPI = false, bool SP2 = false, bool F8 = false>
__device__ __forceinline__ void gemm_phase(PG8_LAS unsigned char* lds, const Gemm g, const Sched& S, const Epi& E) {
    const int tid = threadIdx.x, wid = __builtin_amdgcn_readfirstlane(tid >> 6), lane = tid & 63, wr = wid >> 2, wc = wid & 3, fr = lane & 15, fq = lane >> 4;
    const int K = g.K, nt = K / BK, lda = g.lda ? g.lda : K, ldb = g.ldb ? g.ldb : K;
    unsigned voffA[2], voffB[2];
#pragma unroll
    for (int i = 0; i < 2; ++i) { int R, C; stage_rc(tid * 16 + i * 8192, R, C); const int Rb = Epi::PERM ? ((R & ~31) + perm32(R & 31)) : R;
        voffA[i] = (unsigned)(R * lda + C) * 2u; voffB[i] = (unsigned)(Rb * ldb + C) * 2u; }
    const size_t kstep = (size_t)(BK * 2);
    const size_t hstepA = (size_t)HALF * lda * 2, hstepB = (size_t)HALF * ldb * 2;
    const size_t tstepA = 2 * hstepA, tstepB = 2 * hstepB;
    const unsigned ldsw = (unsigned)wid * 1024u;
    const int aoff = F8 ? lds_byte(wr * 64 + fr, (fq >> 1) * 32 + (fq & 1) * 16) : lds_byte(wr * 64 + fr, fq * 8), boff = F8 ? lds_byte(wc * 32 + fr, (fq >> 1) * 32 + (fq & 1) * 16) : lds_byte(wc * 32 + fr, fq * 8);
    const int aoff1 = F8 ? lds_byte(wr * 64 + fr, (fq >> 1) * 32 + (fq & 1) * 16 + 8) - aoff : 1024, boff1 = F8 ? lds_byte(wc * 32 + fr, (fq >> 1) * 32 + (fq & 1) * 16 + 8) - boff : 1024;
#define PG8_SA(b, h) (((b) * 2 + (h)) * HTB)
#define PG8_SB(b, h) ((4 + (b) * 2 + (h)) * HTB)
#define PG8_STAGE(bufoff, gbase, voff) do { _Pragma("unroll") for (int _i = 0; _i < 2; ++_i) \
        __builtin_amdgcn_global_load_lds((const unsigned*)((const char*)(gbase) + (voff)[_i]), (PG8_LAS unsigned*)(lds + (bufoff) + ldsw + _i * 8192), 16, 0, 0); } while (0)
#define PG8_LDA(dst, b, h) do { if constexpr (F8) { _Pragma("unroll") for (int m = 0; m < 4; ++m) dst##8[m] = __builtin_shufflevector(*(const PG8_LAS i32x4_*)(lds + PG8_SA(b, h) + aoff + m * 2048), *(const PG8_LAS i32x4_*)(lds + PG8_SA(b, h) + aoff + m * 2048 + aoff1), 0, 1, 2, 3, 4, 5, 6, 7); } \
        else { _Pragma("unroll") for (int m = 0; m < 4; ++m) _Pragma("unroll") for (int k = 0; k < 2; ++k) dst[m][k] = *(const PG8_LAS bf16x8*)(lds + PG8_SA(b, h) + aoff + m * 2048 + k * 1024); } } while (0)
#define PG8_LDB(dst, b, h) do { if constexpr (F8) { _Pragma("unroll") for (int n = 0; n < 2; ++n) dst##8[n] = __builtin_shufflevector(*(const PG8_LAS i32x4_*)(lds + PG8_SB(b, h) + boff + n * 2048), *(const PG8_LAS i32x4_*)(lds + PG8_SB(b, h) + boff + n * 2048 + boff1), 0, 1, 2, 3, 4, 5, 6, 7); } \
        else { _Pragma("unroll") for (int n = 0; n < 2; ++n) _Pragma("unroll") for (int k = 0; k < 2; ++k) dst[n][k] = *(const PG8_LAS bf16x8*)(lds + PG8_SB(b, h) + boff + n * 2048 + k * 1024); } } while (0)
#define PG8_MMA(ai, bj, At, Bt) do { __builtin_amdgcn_s_setprio(1); \
        if constexpr (F8) { _Pragma("unroll") for (int m = 0; m < 4; ++m) _Pragma("unroll") for (int n = 0; n < 2; ++n) \
            asm volatile("v_mfma_scale_f32_16x16x128_f8f6f4 %0, %1, %2, %0, %3, %3 op_sel_hi:[0,0,0]" : "+v"(acc[ai][bj][m][n]) : "v"(Bt##8[n]), "v"(At##8[m]), "v"(f8_unit_scale)); } \
        else { _Pragma("unroll") for (int m = 0; m < 4; ++m) _Pragma("unroll") for (int n = 0; n < 2; ++n) _Pragma("unroll") for (int k = 0; k < 2; ++k) \
            acc[ai][bj][m][n] = __builtin_amdgcn_mfma_f32_16x16x32_bf16(Bt[n][k], At[m][k], acc[ai][bj][m][n], 0, 0, 0); } \
        __builtin_amdgcn_s_setprio(0); } while (0)
#define PG8_WAIT_V(n) asm volatile("s_waitcnt vmcnt(" #n ")" ::: "memory")
#define PG8_WAIT_L(n) asm volatile("s_waitcnt lgkmcnt(" #n ")" ::: "memory")
#define PG8_BAR __builtin_amdgcn_s_barrier()
#define PG8_SCHED __builtin_amdgcn_sched_barrier(0)
    Unit cur, nxt; int ui = 0;
    if (!S.next(0, cur)) return;
    f32x4 acc[2][2][4][2];
#pragma unroll
    for (int a = 0; a < 2; ++a)
#pragma unroll
        for (int b = 0; b < 2; ++b)
#pragma unroll
            for (int m = 0; m < 4; ++m)
#pragma unroll
                for (int n = 0; n < 2; ++n) acc[a][b][m][n] = (f32x4){0.f, 0.f, 0.f, 0.f};
    typedef int i32x4_ __attribute__((ext_vector_type(4))); typedef int i32x8_ __attribute__((ext_vector_type(8)));
    const int f8_unit_scale = 0x7F7F7F7F;
    bf16x8 At[4][2], B0[2][2], B1[2][2]; i32x8_ At8[4], B08[2], B18[2];
    const char* cA = (const char*)g.A + (size_t)cur.pm * tstepA + (size_t)cur.aoff * 2; const char* cB = (const char*)g.Bt + (size_t)cur.pn * tstepB + (size_t)cur.boff * 2;
    S.a_ready(cur);
    if constexpr (SP2) {
        PG8_STAGE(PG8_SB(0, 0), cB, voffB); PG8_STAGE(PG8_SB(0, 1), cB + hstepB, voffB); PG8_STAGE(PG8_SA(0, 0), cA, voffA); PG8_STAGE(PG8_SA(0, 1), cA + hstepA, voffA);
        if (wr == 1) PG8_BAR;
        PG8_WAIT_V(2); PG8_BAR;
        PG8_STAGE(PG8_SB(1, 0), cB + kstep, voffB); PG8_STAGE(PG8_SA(1, 0), cA + kstep, voffA); PG8_STAGE(PG8_SB(1, 1), cB + hstepB + kstep, voffB);
        PG8_WAIT_V(6); PG8_BAR;
    } else {
        PG8_STAGE(PG8_SB(0, 0), cB, voffB); PG8_STAGE(PG8_SA(0, 0), cA, voffA); PG8_STAGE(PG8_SB(0, 1), cB + hstepB, voffB); PG8_STAGE(PG8_SA(0, 1), cA + hstepA, voffA);
        if (wr == 1) PG8_BAR;
        PG8_WAIT_V(4); PG8_BAR;
        PG8_STAGE(PG8_SB(1, 0), cB + kstep, voffB); PG8_STAGE(PG8_SA(1, 0), cA + kstep, voffA); PG8_STAGE(PG8_SB(1, 1), cB + hstepB + kstep, voffB);
        PG8_WAIT_V(6); PG8_BAR;
    }
    for (;;) {
        const bool has_next = S.next(ui + 1, nxt);
        const char* nA = has_next ? (const char*)g.A + (size_t)nxt.pm * tstepA + (size_t)nxt.aoff * 2 : cA; const char* nB = has_next ? (const char*)g.Bt + (size_t)nxt.pn * tstepB + (size_t)nxt.boff * 2 : cB;
        for (int t = 0; t < nt; t += 2) {
            const bool last = (t == nt - 2);
            const char* a1 = cA + (size_t)(t + 1) * kstep;
            const char* a2 = last ? nA : cA + (size_t)(t + 2) * kstep; const char* b2 = last ? nB : cB + (size_t)(t + 2) * kstep;
            const char* a3 = a2 + kstep; const char* b3 = b2 + kstep;
            if (last && has_next) S.a_ready(nxt);
            if constexpr (SP2) {
            PG8_LDB(B0, 0, 0); PG8_LDB(B1, 0, 1); PG8_SCHED; PG8_LDA(At, 0, 0); PG8_STAGE(PG8_SA(1, 1), a1 + hstepA, voffA);
            PG8_WAIT_V(8); PG8_WAIT_L(0); PG8_BAR; PG8_MMA(0, 0, At, B0); PG8_MMA(0, 1, At, B1); PG8_BAR; PG8_SCHED;
            PG8_LDA(At, 0, 1); PG8_STAGE(PG8_SB(0, 0), b2, voffB); PG8_STAGE(PG8_SB(0, 1), b2 + hstepB, voffB); PG8_STAGE(PG8_SA(0, 0), a2, voffA);
            PG8_WAIT_V(8); PG8_WAIT_L(0); PG8_BAR; PG8_MMA(1, 0, At, B0); PG8_MMA(1, 1, At, B1); PG8_BAR; PG8_SCHED;
            PG8_LDB(B0, 1, 0); PG8_LDB(B1, 1, 1); PG8_SCHED; PG8_LDA(At, 1, 0); PG8_STAGE(PG8_SA(0, 1), a2 + hstepA, voffA);
            PG8_WAIT_V(8); PG8_WAIT_L(0); PG8_BAR; PG8_MMA(0, 0, At, B0); PG8_MMA(0, 1, At, B1); PG8_BAR; PG8_SCHED;
            PG8_LDA(At, 1, 1); PG8_STAGE(PG8_SB(1, 0), b3, voffB); PG8_STAGE(PG8_SB(1, 1), b3 + hstepB, voffB); PG8_STAGE(PG8_SA(1, 0), a3, voffA);
            PG8_WAIT_V(8); PG8_WAIT_L(0); PG8_BAR; PG8_MMA(1, 0, At, B0); PG8_MMA(1, 1, At, B1); PG8_BAR; PG8_SCHED;
            } else {
            PG8_LDB(B0, 0, 0); PG8_SCHED; PG8_LDA(At, 0, 0); PG8_STAGE(PG8_SA(1, 1), a1 + hstepA, voffA);
            PG8_WAIT_L(8); PG8_BAR; PG8_WAIT_L(0); PG8_MMA(0, 0, At, B0); PG8_BAR; PG8_SCHED;
            PG8_LDB(B1, 0, 1); PG8_STAGE(PG8_SB(0, 0), b2, voffB);
            PG8_BAR; PG8_WAIT_L(0); PG8_MMA(0, 1, At, B1); PG8_BAR;
            PG8_LDA(At, 0, 1); PG8_STAGE(PG8_SA(0, 0), a2, voffA);
            PG8_BAR; PG8_WAIT_L(0); PG8_MMA(1, 0, At, B0); PG8_BAR; PG8_SCHED;
            PG8_STAGE(PG8_SB(0, 1), b2 + hstepB, voffB);
            PG8_WAIT_V(6); PG8_BAR; PG8_MMA(1, 1, At, B1); PG8_BAR;
            PG8_LDB(B0, 1, 0); PG8_SCHED; PG8_LDA(At, 1, 0); PG8_STAGE(PG8_SA(0, 1), a2 + hstepA, voffA);
            PG8_WAIT_L(8); PG8_BAR; PG8_WAIT_L(0); PG8_MMA(0, 0, At, B0); PG8_BAR; PG8_SCHED;
            PG8_LDB(B1, 1, 1); PG8_STAGE(PG8_SB(1, 0), b3, voffB);
            PG8_BAR; PG8_WAIT_L(0); PG8_MMA(0, 1, At, B1); PG8_BAR;
            PG8_LDA(At, 1, 1); PG8_STAGE(PG8_SA(1, 0), a3, voffA);
            PG8_BAR; PG8_WAIT_L(0); PG8_MMA(1, 0, At, B0); PG8_BAR; PG8_SCHED;
            PG8_STAGE(PG8_SB(1, 1), b3 + hstepB, voffB);
            PG8_WAIT_V(6); PG8_BAR; PG8_MMA(1, 1, At, B1); PG8_BAR;
            }
        }
        if constexpr (F8) asm volatile("s_nop 15\n\ts_nop 15\n\ts_nop 15\n\ts_nop 15" ::: "memory");
        if constexpr (ALIGN_EPI) { if (wr == 0) PG8_BAR; }
        if constexpr (!Epi::AFTER_DRAIN) { E(acc, cur, wr, wc, fr, fq); S.done(cur); }
        if (!has_next) break;
        if (!(EpiChain<Epi>::value && cur.aux == 0)) {
#pragma unroll
        for (int a = 0; a < 2; ++a)
#pragma unroll
            for (int b = 0; b < 2; ++b)
#pragma unroll
                for (int m = 0; m < 4; ++m)
#pragma unroll
                    for (int n = 0; n < 2; ++n) acc[a][b][m][n] = (f32x4){0.f, 0.f, 0.f, 0.f};
        }
        cur = nxt; cA = nA; cB = nB; ++ui;
        if constexpr (ALIGN_EPI) { if (wr == 1) PG8_BAR; }
    }
    PG8_WAIT_V(0);
    if constexpr (!ALIGN_EPI) { if (wr == 0) PG8_BAR; }
    PG8_BAR;
    if constexpr (Epi::AFTER_DRAIN) { E.fused(acc, cur, wr, wc, fr, fq, lds, wid, lane); S.done(cur); }
#undef PG8_SA
#undef PG8_SB
#undef PG8_STAGE
#undef PG8_LDA
#undef PG8_LDB
#undef PG8_MMA
#undef PG8_WAIT_V
#undef PG8_WAIT_L
#undef PG8_BAR
#undef PG8_SCHED
}
}
#define GAS __attribute__((address_space(1)))
#define LAS __attribute__((address_space(3)))
typedef unsigned short bf16;
typedef unsigned v4u __attribute__((ext_vector_type(4)));
typedef float f32x4 __attribute__((ext_vector_type(4)));
typedef short bf16x8 __attribute__((ext_vector_type(8)));
typedef GAS unsigned gu32;
typedef GAS unsigned long long gu64;
#define RLX_AGENT __ATOMIC_RELAXED, __HIP_MEMORY_SCOPE_AGENT
#define LDS_WAIT() asm volatile("s_waitcnt lgkmcnt(0)" ::: "memory")
#define VM_WAIT() asm volatile("s_waitcnt vmcnt(0)" ::: "memory")
__device__ __forceinline__ unsigned long long rt() { return __builtin_amdgcn_s_memrealtime(); }
__device__ __forceinline__ unsigned f2bf(float f) { unsigned u = __builtin_bit_cast(unsigned, f); return (u + 0x7fffu + ((u >> 16) & 1u)) >> 16; }
__device__ __forceinline__ unsigned pk2(float lo, float hi) { return f2bf(lo) | (f2bf(hi) << 16); }

#define XB_TMO      128
#define XB_XCNT(j)  (256  + 64 * (j))
#define XB_XSUB(j)  (1280 + 64 * (j))
#define XB_XGEN(j)  (2304 + 64 * (j))
#define XB_TOP      3328
#define XB_TOPGEN   3392
#define XCD_BAR_WORDS 3456
#define XB_SPIN_CAP (1u << 18)

__device__ __forceinline__ unsigned xb_ld(unsigned* p)              { return __hip_atomic_load(p, __ATOMIC_RELAXED, __HIP_MEMORY_SCOPE_AGENT); }
__device__ __forceinline__ unsigned xb_add(unsigned* p, unsigned v) { return __hip_atomic_fetch_add(p, v, __ATOMIC_RELAXED, __HIP_MEMORY_SCOPE_AGENT); }
__device__ __forceinline__ unsigned xb_xcc_id() { return (unsigned)__builtin_amdgcn_s_getreg((3 << 11) | 20) & 0xFu; }
#define XB_SPIN(cond, bar) do { unsigned _sp = 0; while (cond) { __builtin_amdgcn_s_sleep(1); \
    if ((++_sp & 255u) == 0u) { if (xb_ld(&(bar)[XB_TMO])) break; if (_sp > XB_SPIN_CAP) { atomicAdd(&(bar)[XB_TMO], 1u); break; } } } } while (0)

struct XcdBarrier {
    unsigned* bar; unsigned x;
    volatile LAS unsigned* st;
};

__device__ __forceinline__ XcdBarrier xcd_barrier_post(unsigned* bar, volatile LAS unsigned* st) {
    XcdBarrier b; b.bar = bar; b.x = xb_xcc_id(); b.st = st;
    if (threadIdx.x == 0) (void)xb_add(&bar[XB_XCNT(b.x)], 1u);
    return b;
}
__device__ __forceinline__ void xcd_barrier_complete(unsigned* bar, unsigned x, unsigned& nloc, unsigned& nx) {
    const unsigned G = gridDim.x * gridDim.y * gridDim.z;
    unsigned sum, cnt, mine, sp = 0u;
    for (;;) {
        sum = 0u; cnt = 0u; mine = 0u;
#pragma unroll
        for (unsigned j = 0; j < 16; ++j) { const unsigned c = xb_ld(&bar[XB_XCNT(j)]); sum += c; cnt += (c > 0u) ? 1u : 0u; mine = (j == x) ? c : mine; }
        if (sum == G) break;
        __builtin_amdgcn_s_sleep(1);
        if ((++sp & 255u) == 0u) { if (xb_ld(&bar[XB_TMO])) break; if (sp > XB_SPIN_CAP) { atomicAdd(&bar[XB_TMO], 1u); break; } }
    }
    nloc = mine > 0u ? mine : 1u; nx = cnt > 0u ? cnt : 1u;
}

__device__ __forceinline__ void xcd_barrier(const XcdBarrier& b) {
    asm volatile("s_waitcnt vmcnt(0)" ::: "memory");
    __syncthreads();
    if (threadIdx.x == 0) {
        unsigned* bar = b.bar;
        __builtin_amdgcn_s_waitcnt(0);
        unsigned nloc = b.st[0], nx = b.st[1];
        if (nloc == 0u) { xcd_barrier_complete(bar, b.x, nloc, nx); b.st[0] = nloc; b.st[1] = nx; }
        const unsigned old = xb_add(&bar[XB_XSUB(b.x)], 1u);
        const unsigned gen = old / nloc;
        if (old + 1u == (gen + 1u) * nloc) {
            __builtin_amdgcn_fence(__ATOMIC_RELEASE, "agent");
            asm volatile("s_waitcnt vmcnt(0)" ::: "memory");
            const unsigned og = xb_add(&bar[XB_TOP], 1u);
            const unsigned tg = og / nx;
            if (og + 1u == (tg + 1u) * nx) xb_add(&bar[XB_TOPGEN], 1u);
            else XB_SPIN(xb_ld(&bar[XB_TOPGEN]) == tg, bar);
            __builtin_amdgcn_fence(__ATOMIC_ACQUIRE, "agent");
            xb_add(&bar[XB_XGEN(b.x)], 1u);
            asm volatile("s_waitcnt vmcnt(0)" ::: "memory");
        } else {
            XB_SPIN(xb_ld(&bar[XB_XGEN(b.x)]) == gen, bar);
            __builtin_amdgcn_fence(__ATOMIC_ACQUIRE, "agent");
            asm volatile("s_waitcnt vmcnt(0)" ::: "memory");
        }
    }
    __syncthreads();
}
__device__ __forceinline__ float wave_sum(float v) {
#pragma unroll
    for (int o = 1; o < 64; o <<= 1) v += __shfl_xor(v, o);
    return v;
}
__device__ __forceinline__ void p0_transpose_item(const float* W, int K, int N, bf16* WT, int row_off, LAS float* scr, int item, int lane, int ldw = 0, unsigned char* W8 = nullptr, int n8_lo = 0, int n8_hi = 0, float s8 = 1.f) {
    if (ldw == 0) ldw = K;
    const int nblk = N / 32, kb = item / nblk, nb = item % nblk, k0 = 64 * kb, n0 = 32 * nb;
    float tv[32];
#pragma unroll
    for (int i = 0; i < 32; ++i) tv[i] = __builtin_nontemporal_load(W + (size_t)(k0 + 2 * i + (lane >> 5)) * N + n0 + (lane & 31));
#pragma unroll
    for (int i = 0; i < 32; ++i) scr[(2 * i + (lane >> 5)) * 33 + (lane & 31)] = tv[i];
    LDS_WAIT(); asm volatile("" ::: "memory");
    const int c = lane & 7;
#pragma unroll
    for (int j = 0; j < 4; ++j) { const int n = (lane >> 3) + 8 * j; const LAS float* s = scr + (8 * c) * 33 + n;
        if (W8 && n0 >= n8_lo && n0 < n8_hi) { int a = 0, b = 0;
            a = __builtin_amdgcn_cvt_pk_fp8_f32(s[0 * 33] * s8, s[1 * 33] * s8, a, false); a = __builtin_amdgcn_cvt_pk_fp8_f32(s[2 * 33] * s8, s[3 * 33] * s8, a, true);
            b = __builtin_amdgcn_cvt_pk_fp8_f32(s[4 * 33] * s8, s[5 * 33] * s8, b, false); b = __builtin_amdgcn_cvt_pk_fp8_f32(s[6 * 33] * s8, s[7 * 33] * s8, b, true);
            typedef unsigned u32x2h __attribute__((ext_vector_type(2))); *(GAS u32x2h*)(W8 + (size_t)(n0 - n8_lo + n) * K + k0 + 8 * c) = (u32x2h){(unsigned)a, (unsigned)b}; }
        else { v4u o; o.x = pk2(s[0 * 33], s[1 * 33]); o.y = pk2(s[2 * 33], s[3 * 33]); o.z = pk2(s[4 * 33], s[5 * 33]); o.w = pk2(s[6 * 33], s[7 * 33]);
            *(GAS v4u*)(WT + (size_t)(row_off + n0 + n) * ldw + k0 + 8 * c) = o; } }
    LDS_WAIT(); asm volatile("" ::: "memory");
}

constexpr int NWAVES = 8;
#ifndef MK_N_LAUNCHES
#define MK_N_LAUNCHES 1
#endif
constexpr int NPH = 13;
constexpr int N_LAUNCHES = MK_N_LAUNCHES;
static_assert(N_LAUNCHES == 1 || N_LAUNCHES == NPH, "MK_N_LAUNCHES is 1 or NPH");

constexpr int TOK = 8192, DM = 2048, SEQ = 4096, NIN = 9216, MEMT = 512;
constexpr float EPS = 1e-6f;
constexpr size_t MiB = 1u << 20;
constexpr size_t WS_CTL = 0, CTL_ZERO_BYTES = 32 * 1024;
constexpr size_t WS_SUBK = 1 * MiB;
constexpr size_t WS_PS1 = 2 * MiB, WS_PS2 = 3 * MiB;
constexpr size_t WS_WIN = 4 * MiB;
constexpr size_t WS_WUPA = 40 * MiB, WS_WUPB = 44 * MiB;
constexpr size_t WS_WOUT = 48 * MiB, WS_WMQ = 56 * MiB, WS_WMKV = 64 * MiB, WS_WMO = 80 * MiB, WS_WPQ = 88 * MiB;
constexpr size_t WS_PU = 96 * MiB, WS_PV = 160 * MiB;
constexpr size_t WS_S0 = 224 * MiB;
constexpr size_t WS_S1 = 256 * MiB;
constexpr size_t WS_S2 = 288 * MiB;
constexpr size_t WS_S3 = 320 * MiB;
constexpr size_t WS_S4 = 352 * MiB;
constexpr size_t WS_S6 = 416 * MiB;
constexpr size_t WS_KM = 480 * MiB, WS_MN = 484 * MiB, WS_END = 486 * MiB;
constexpr size_t WS_A0F8 = 432 * MiB, WS_WIN8 = 448 * MiB;
constexpr size_t WS_WMKV8 = 464 * MiB, WS_MN8 = 472 * MiB;
constexpr size_t WS_WKT = 176 * MiB, WS_VWOT = 184 * MiB;
constexpr int CW_TMO = 0, CW_CODE = 1, CW_BAR = 4096;

constexpr int TAB1 = 9728;
constexpr int RING_OFF = 0, RING_BYTES = 131072;
constexpr int LDSCTL_OFF = RING_BYTES, MISC_OFF = LDSCTL_OFF + 320;
constexpr int LDS_BYTES = 147456;

typedef float f32x2g __attribute__((ext_vector_type(2)));
typedef unsigned u32x2 __attribute__((ext_vector_type(2)));
#define DI __device__ __forceinline__
#define MFMA16(a, b, c) __builtin_amdgcn_mfma_f32_16x16x32_bf16((a), (b), (c), 0, 0, 0)

struct Frame {
    LAS unsigned char* lds;
    volatile LAS unsigned* MISC;
    gu32* ctl;
    int tid, lane, wave, vcu, G;
    const float* in[23];
    float* out; unsigned char* ws;
};
enum { I_X = 0, I_MEM, I_GMIX, I_WIN, I_LNG, I_LNB, I_WS, I_BS, I_RELB, I_WUPA, I_WUPB, I_WOUT, I_GMQ, I_GMKV, I_MWQ, I_MWKV, I_MWO, I_GFFN, I_PWQ, I_SUBK, I_PU, I_PV, I_GFIN };

DI float wave_max(float v) {
#pragma unroll
    for (int o = 1; o < 64; o <<= 1) v = fmaxf(v, __shfl_xor(v, o));
    return v;
}
DI float gelu1(float v) {
    const float av = fabsf(v), t = __builtin_amdgcn_rcpf(av * 0.2316418882f + 1.0f);
    float q = t * 0.5307027145f + (-0.7265760135f); q = q * t + 0.7107068705f; q = q * t + (-0.142248368f); q = q * t + 0.127414796f; q = q * t;
    const float e = __builtin_amdgcn_exp2f((v * v) * (-0.72134752044f)); const float m = v * (q * e);
    return v < 0.f ? m : v - m;
}
DI float bflo(unsigned w) { return __builtin_bit_cast(float, w << 16); }
DI float bfhi(unsigned w) { return __builtin_bit_cast(float, w & 0xffff0000u); }

DI void rms_row_to_bf16(int lane, const float* xrow, const float* gain, bf16* orow, unsigned char* o8row = nullptr, float s8 = 1.f) {
    const GAS f32x4* xr = (const GAS f32x4*)xrow + lane; const GAS f32x4* gr = (const GAS f32x4*)gain + lane;
    f32x4 v[8]; float s = 0.f;
#pragma unroll
    for (int j = 0; j < 8; ++j) { v[j] = __builtin_nontemporal_load(xr + 64 * j); s += (v[j].x * v[j].x + v[j].y * v[j].y) + (v[j].z * v[j].z + v[j].w * v[j].w); }
    const float rstd = 1.0f / sqrtf(wave_sum(s) * (1.f / DM) + EPS);
    GAS unsigned long long* o8 = (GAS unsigned long long*)orow + lane;
#pragma unroll
    for (int j = 0; j < 8; ++j) { const f32x4 g = gr[64 * j];
        o8[64 * j] = (unsigned long long)pk2(v[j].x * rstd * g.x, v[j].y * rstd * g.y) | ((unsigned long long)pk2(v[j].z * rstd * g.z, v[j].w * rstd * g.w) << 32);
        if (o8row) { int a = 0; const float r8 = rstd * s8; a = __builtin_amdgcn_cvt_pk_fp8_f32(v[j].x * r8 * g.x, v[j].y * r8 * g.y, a, false); a = __builtin_amdgcn_cvt_pk_fp8_f32(v[j].z * r8 * g.z, v[j].w * r8 * g.w, a, true);
            *((GAS unsigned*)o8row + lane + 64 * j) = (unsigned)a; } }
}
DI void peer_tables(Frame& F, int gw, int NGW, int r_lo, int r_hi) {
    unsigned char* ws = F.ws;
    {
            unsigned char* PU4 = ws + WS_PU; float* FS = (float*)(ws + WS_PU + 64 * MiB);
            for (int r0 = r_lo + gw; r0 < r_hi; r0 += 2 * NGW) {
                const int rr[2] = {r0, r0 + NGW < r_hi ? r0 + NGW : r0};
                f32x4 v[2][8]; float am[2] = {0.f, 0.f};
#pragma unroll
                for (int k = 0; k < 2; ++k) { const int r = rr[k]; const bool second = r >= 16384; const float* src = (second ? F.in[I_PV] : F.in[I_PU]) + (size_t)(second ? r - 16384 : r) * DM + 4 * F.lane;
#pragma unroll
                    for (int i = 0; i < 8; ++i) v[k][i] = __builtin_nontemporal_load((const GAS f32x4*)(src + 256 * i)); }
#pragma unroll
                for (int k = 0; k < 2; ++k) { const int r = rr[k];
#pragma unroll
                    for (int i = 0; i < 8; ++i) am[k] = fmaxf(am[k], fmaxf(fmaxf(fabsf(v[k][i].x), fabsf(v[k][i].y)), fmaxf(fabsf(v[k][i].z), fabsf(v[k][i].w))));
                    am[k] = wave_max(am[k]); const float inv = am[k] > 0.f ? 6.0f / am[k] : 0.f;
                    unsigned w[4];
#pragma unroll
                    for (int c = 0; c < 4; ++c) { unsigned x = 0u;
                        x = __builtin_amdgcn_cvt_scalef32_pk_fp4_f32(x, v[k][2 * c].x * inv, v[k][2 * c].y * inv, 1.0f, 0); x = __builtin_amdgcn_cvt_scalef32_pk_fp4_f32(x, v[k][2 * c].z * inv, v[k][2 * c].w * inv, 1.0f, 1);
                        x = __builtin_amdgcn_cvt_scalef32_pk_fp4_f32(x, v[k][2 * c + 1].x * inv, v[k][2 * c + 1].y * inv, 1.0f, 2); x = __builtin_amdgcn_cvt_scalef32_pk_fp4_f32(x, v[k][2 * c + 1].z * inv, v[k][2 * c + 1].w * inv, 1.0f, 3);
                        w[c] = x; }
                    *((GAS v4u*)(PU4 + (size_t)r * 1024) + F.lane) = (v4u){w[0], w[1], w[2], w[3]};
                    if (F.lane == 0) FS[r] = am[k] * (1.0f / 6.0f); }
            }
        }
}
#ifndef DBG_P0DUP
#define DBG_P0DUP 0
#endif
DI void p0_prologue(Frame& F, int gw, int NGW, int part) {
    int ln = F.lane; asm volatile("" : "+v"(ln));
    LAS float* scr = (LAS float*)(F.lds + RING_OFF + F.wave * 16384);
    unsigned char* ws = F.ws;
    constexpr int I_IN = (DM / 64) * (NIN / 32), I_UP = (1024 / 64) * (DM / 32), I_SQ = (DM / 64) * (DM / 32), I_KV = (DM / 64) * (4096 / 32);
    if (part & 1) for (int it = gw; it < I_IN + I_SQ + I_KV; it += NGW) {
        int r = it;
        if (r < I_IN) { p0_transpose_item(F.in[I_WIN], DM, NIN, (bf16*)(ws + WS_WIN), 0, scr, r, ln, 0, ws + WS_WIN8, 2048, NIN, 256.0f); continue; } r -= I_IN;
        if (r < I_SQ) { p0_transpose_item(F.in[I_MWO], DM, DM, (bf16*)(ws + WS_WMO), 0, scr, r, ln); continue; } r -= I_SQ;
        p0_transpose_item(F.in[I_MWKV], DM, 4096, (bf16*)(ws + WS_WMKV), 0, scr, r, ln, 0, ws + WS_WMKV8, 0, 4096, 256.0f);
    }
    if (part & 2) for (int it = gw; it < 2 * I_UP + I_SQ; it += NGW) {
        int r = it;
        if (r < I_UP) { p0_transpose_item(F.in[I_WUPA], 1024, DM, (bf16*)(ws + WS_WUPA), 0, scr, r, ln, 0, ws + WS_WUPA, 0, DM, 256.0f); continue; } r -= I_UP;
        if (r < I_UP) { p0_transpose_item(F.in[I_WUPB], 1024, DM, (bf16*)(ws + WS_WUPB), 0, scr, r, ln, 0, ws + WS_WUPB, 0, DM, 256.0f); continue; } r -= I_UP;
        p0_transpose_item(F.in[I_WOUT], DM, DM, (bf16*)(ws + WS_WOUT), 0, scr, r, ln, 0, ws + WS_WOUT, 0, DM, 256.0f);
    }
    if (part & 1) for (int it = gw; it < 16 * 32 * 4; it += NGW) {
        const int hp = it >> 7, kb = ((it >> 2) & 31) * 64, mq = it & 3, pp = hp & 1, fr = ln & 15, fq = ln >> 4;
        const float* Ag = F.in[I_SUBK] + (size_t)pp * 128 * 128 + (size_t)(32 * mq + fr) * 128 + 8 * fq; const float* Bg = F.in[I_PWQ] + (size_t)(kb + fr) * DM + hp * 128 + 8 * fq;
        f32x4 bl[4][4][2], al[4][2][2];
#pragma unroll
        for (int ks = 0; ks < 4; ++ks) {
#pragma unroll
            for (int n = 0; n < 4; ++n) { const float* p = Bg + (size_t)(16 * n) * DM + ks * 32; bl[ks][n][0] = *(const GAS f32x4*)p; bl[ks][n][1] = *(const GAS f32x4*)(p + 4); }
#pragma unroll
            for (int m = 0; m < 2; ++m) { const float* p = Ag + (size_t)(16 * m) * 128 + ks * 32; al[ks][m][0] = *(const GAS f32x4*)p; al[ks][m][1] = *(const GAS f32x4*)(p + 4); }
        }
        f32x4 acc[2][4];
#pragma unroll
        for (int m = 0; m < 2; ++m)
#pragma unroll
            for (int n = 0; n < 4; ++n) acc[m][n] = (f32x4){0.f, 0.f, 0.f, 0.f};
#pragma unroll
        for (int ks = 0; ks < 4; ++ks) {
            bf16x8 bfr[4];
#pragma unroll
            for (int n = 0; n < 4; ++n) { const f32x4 a = bl[ks][n][0], b = bl[ks][n][1]; const v4u w = (v4u){pk2(a.x, a.y), pk2(a.z, a.w), pk2(b.x, b.y), pk2(b.z, b.w)}; bfr[n] = __builtin_bit_cast(bf16x8, w); }
#pragma unroll
            for (int m = 0; m < 2; ++m) { const f32x4 a = al[ks][m][0], b = al[ks][m][1]; const v4u w = (v4u){pk2(a.x, a.y), pk2(a.z, a.w), pk2(b.x, b.y), pk2(b.z, b.w)}; const bf16x8 afr = __builtin_bit_cast(bf16x8, w);
#pragma unroll
                for (int n = 0; n < 4; ++n) acc[m][n] = __builtin_amdgcn_mfma_f32_16x16x32_bf16(bfr[n], afr, acc[m][n], 0, 0, 0); }
        }
        bf16* WF = (bf16*)(ws + WS_WPQ);
#pragma unroll
        for (int m = 0; m < 2; ++m)
#pragma unroll
            for (int n = 0; n < 4; ++n) { typedef unsigned u32x2l __attribute__((ext_vector_type(2))); u32x2l o; o.x = pk2(acc[m][n][0], acc[m][n][1]); o.y = pk2(acc[m][n][2], acc[m][n][3]);
                *(GAS u32x2l*)(WF + (size_t)(hp * 128 + 32 * mq + 16 * m + fr) * DM + kb + 16 * n + 4 * fq) = o; }
    }
    if (!(part & 1)) return;
    {
        const size_t gt = (size_t)gw * 64 + ln, NT = (size_t)NGW * 64;
        for (size_t i = gt; i < (size_t)DM * DM / 8; i += NT) {
            const GAS f32x4* s = (const GAS f32x4*)F.in[I_MWQ] + 2 * i; const f32x4 a = __builtin_nontemporal_load(s), b = __builtin_nontemporal_load(s + 1);
            v4u o; o.x = pk2(a.x, a.y); o.y = pk2(a.z, a.w); o.z = pk2(b.x, b.y); o.w = pk2(b.z, b.w);
            *((GAS v4u*)(ws + WS_WMQ) + i) = o;
        }
    }
    for (int dup = 0; dup < ((DBG_P0DUP & 4) ? 2 : 1); ++dup)
    for (int m = gw; m < TOK; m += NGW) rms_row_to_bf16(ln, F.in[I_X] + (size_t)m * DM, F.in[I_GMIX], (bf16*)(ws + WS_S0) + (size_t)m * DM, ws + WS_A0F8 + (size_t)m * DM, 16.0f);
    for (int m = gw; m < MEMT; m += NGW) rms_row_to_bf16(ln, F.in[I_MEM] + (size_t)m * DM, F.in[I_GMKV], (bf16*)(ws + WS_MN) + (size_t)m * DM, ws + WS_MN8 + (size_t)m * DM, 16.0f);
}

DI void sg_unit(Frame& F, int unit) {
    const int blk = unit >> 2, g = unit & 3, tid = F.tid, lane = F.lane, w = F.wave, fr = lane & 15, fq = lane >> 4;
    LAS float* RED = (LAS float*)(F.lds);
    LAS float* ST = (LAS float*)(F.lds + 8192);
    LAS float* R01 = (LAS float*)(F.lds + 9216);
    LAS bf16* WP = (LAS bf16*)(F.lds + 10240);
    const bf16* ZVT = (const bf16*)(F.ws + WS_S1 + 16 * MiB) + (size_t)blk * 1024 * 128;
    __syncthreads();
    if (tid < 128) {
        const GAS f32x4* ps = (const GAS f32x4*)((const float*)(F.ws + WS_SUBK) + (size_t)(blk * 128 + tid) * 32); float s = 0.f, q = 0.f;
#pragma unroll
        for (int k = 0; k < 8; ++k) { const f32x4 t = ps[k]; s += t.x + t.z; q += t.y + t.w; }
        const float mean = s * (1.f / 1024.f); float var = q * (1.f / 1024.f) - mean * mean; var = var < 0.f ? 0.f : var;
        ST[tid * 2] = mean; ST[tid * 2 + 1] = 1.0f / sqrtf(var + EPS); }
    __syncthreads();
    {
        const float* Wg = F.in[I_WS] + (size_t)g * 128 * 128;
#pragma unroll
        for (int k = 0; k < 4; ++k) { const int id = tid + 512 * k, i = id >> 4, j0 = (id & 15) * 8;
            const f32x4 a = *(const GAS f32x4*)(Wg + i * 128 + j0), b = *(const GAS f32x4*)(Wg + i * 128 + j0 + 4);
            const float mk = ((i >> 6) >= (j0 >> 6)) ? 1.f : 0.f;
            float v[8] = {a.x, a.y, a.z, a.w, b.x, b.y, b.z, b.w}; unsigned o[4]; float r0 = 0.f, r1 = 0.f;
#pragma unroll
            for (int e = 0; e < 4; ++e) { o[e] = pk2(v[2 * e] * mk * ST[(j0 + 2 * e) * 2 + 1], v[2 * e + 1] * mk * ST[(j0 + 2 * e + 1) * 2 + 1]);
                r0 += (v[2 * e] + v[2 * e + 1]) * mk; r1 += bflo(o[e]) * ST[(j0 + 2 * e) * 2] + bfhi(o[e]) * ST[(j0 + 2 * e + 1) * 2]; }
            *(LAS v4u*)(WP + i * 136 + j0) = (v4u){o[0], o[1], o[2], o[3]};
#pragma unroll
            for (int sft = 1; sft < 16; sft <<= 1) { r0 += __shfl_xor(r0, sft); r1 += __shfl_xor(r1, sft); }
            if ((id & 15) == 0) { R01[i * 2] = r0; R01[i * 2 + 1] = r1; } }
    }
    __syncthreads();
    const int wr = w >> 2, wc = w & 3;
    f32x4 acc[4][4];
#pragma unroll
    for (int m = 0; m < 4; ++m)
#pragma unroll
        for (int n = 0; n < 4; ++n) acc[m][n] = (f32x4){0.f, 0.f, 0.f, 0.f};
    const bf16* Bg = ZVT + (size_t)(g * 256 + wc * 64 + fr) * 128 + 8 * fq;
#pragma unroll
    for (int ks = 0; ks < 4; ++ks) {
        bf16x8 bfrag[4], afrag[4];
#pragma unroll
        for (int n = 0; n < 4; ++n) bfrag[n] = *(const GAS bf16x8*)(Bg + (size_t)(16 * n) * 128 + ks * 32);
#pragma unroll
        for (int m = 0; m < 4; ++m) afrag[m] = *(const LAS bf16x8*)(WP + (wr * 64 + 16 * m + fr) * 136 + ks * 32 + 8 * fq);
#pragma unroll
        for (int m = 0; m < 4; ++m)
#pragma unroll
            for (int n = 0; n < 4; ++n) acc[m][n] = MFMA16(bfrag[n], afrag[m], acc[m][n]);
    }
    const bf16* ZU = (const bf16*)(F.ws + WS_S1); bf16* YA = (bf16*)(F.ws + WS_S3);
#pragma unroll
    for (int m = 0; m < 4; ++m) { const int i = wr * 64 + 16 * m + fr; const float r0 = R01[i * 2], r1 = R01[i * 2 + 1], bs = F.in[I_BS][g * 128 + i]; const size_t trow = (size_t)(blk * 128 + i) * 1024;
#pragma unroll
        for (int n = 0; n < 4; ++n) { const int ch = g * 256 + wc * 64 + 16 * n + 4 * fq;
            const f32x4 lg = *(const GAS f32x4*)(F.in[I_LNG] + ch), lb = *(const GAS f32x4*)(F.in[I_LNB] + ch);
            const u32x2 zu = *(const GAS u32x2*)(ZU + trow + ch);
            const float s0 = lg.x * (acc[m][n][0] - r1) + lb.x * r0 + bs, s1 = lg.y * (acc[m][n][1] - r1) + lb.y * r0 + bs, s2 = lg.z * (acc[m][n][2] - r1) + lb.z * r0 + bs, s3 = lg.w * (acc[m][n][3] - r1) + lb.w * r0 + bs;
            int o8 = 0; o8 = __builtin_amdgcn_cvt_pk_fp8_f32(bflo(zu.x) * s0 * 8.0f, bfhi(zu.x) * s1 * 8.0f, o8, false); o8 = __builtin_amdgcn_cvt_pk_fp8_f32(bflo(zu.y) * s2 * 8.0f, bfhi(zu.y) * s3 * 8.0f, o8, true);
            *(GAS unsigned*)((unsigned char*)YA + trow + ch) = (unsigned)o8; } }
}

DI void attn_unit(Frame& F, int unit) {
    const int cp = unit & 31, h = (unit >> 5) & 7, b = unit >> 8, tid = F.tid, lane = F.lane, w = F.wave, fr = lane & 15, fq = lane >> 4;
    LAS bf16* QL = (LAS bf16*)(F.lds);
    LAS bf16* KL = QL + 128 * 136;
    LAS bf16* VL = KL + 64 * 136;
    LAS bf16* PL = VL + 128 * 72;
    LAS float* BL = (LAS float*)(PL + 8 * 16 * 72);
    const bf16* QK = (const bf16*)(F.ws + WS_S2); const bf16* VT = (const bf16*)(F.ws + WS_S6); bf16* YB = (bf16*)(F.ws + WS_S3 + 16 * MiB);
    const int t0 = cp * 128, cq = 2 * cp + (w >> 2);
    const int kt_lo = (2 * cp - 8) < 0 ? 0 : (2 * cp - 8), kt_hi = 2 * cp + 1;
    __syncthreads();
    for (int i = tid; i < 257; i += 512) BL[i] = F.in[I_RELB][h * 257 + i];
#pragma unroll
    for (int k = 0; k < 4; ++k) { const int id = tid + 512 * k, r = id >> 4, ch = id & 15;
        *(LAS v4u*)(QL + r * 136 + ch * 8) = *(const GAS v4u*)(QK + (size_t)(b * SEQ + t0 + r) * 2048 + h * 128 + ch * 8); }
    v4u kreg[2][2], vreg[2][2];
#define ATT_PREFETCH(kt, S) do { _Pragma("unroll") for (int k = 0; k < 2; ++k) { const int id = tid + 512 * k; \
        kreg[S][k] = *(const GAS v4u*)(QK + (size_t)(b * SEQ + (kt) * 64 + (id >> 4)) * 2048 + 1024 + h * 128 + (id & 15) * 8); \
        vreg[S][k] = *(const GAS v4u*)(VT + (size_t)((b * 8 + h) * 128 + (id >> 3)) * 4096 + (kt) * 64 + (id & 7) * 8); } } while (0)
    ATT_PREFETCH(kt_lo, 0); if (kt_lo + 1 <= kt_hi) ATT_PREFETCH(kt_lo + 1, 1);
    f32x4 o[8]; float m_run = -1e30f, l_run = 0.f;
#pragma unroll
    for (int n = 0; n < 8; ++n) o[n] = (f32x4){0.f, 0.f, 0.f, 0.f};
    bf16x8 qf[4];
    for (int kt0 = kt_lo; kt0 <= kt_hi; kt0 += 2)
#pragma unroll
    for (int par = 0; par < 2; ++par) { const int kt = kt0 + par; if (kt > kt_hi) break;
        LDS_WAIT(); __builtin_amdgcn_s_barrier(); asm volatile("" ::: "memory");
#pragma unroll
        for (int k = 0; k < 2; ++k) { const int id = tid + 512 * k; *(LAS v4u*)(KL + (id >> 4) * 136 + (id & 15) * 8) = kreg[par][k]; *(LAS v4u*)(VL + (id >> 3) * 72 + (id & 7) * 8) = vreg[par][k]; }
        LDS_WAIT(); __builtin_amdgcn_s_barrier(); asm volatile("" ::: "memory");
        if (kt == kt_lo) {
#pragma unroll
            for (int ks = 0; ks < 4; ++ks) qf[ks] = *(const LAS bf16x8*)(QL + (16 * w + fr) * 136 + ks * 32 + 8 * fq);
        }
        if (kt + 2 <= kt_hi) ATT_PREFETCH(kt + 2, par);
        if (kt >= cq - 8 && kt <= cq) {
            f32x4 s[4];
#pragma unroll
            for (int n = 0; n < 4; ++n) s[n] = (f32x4){0.f, 0.f, 0.f, 0.f};
#pragma unroll
            for (int ks = 0; ks < 4; ++ks)
#pragma unroll
                for (int n = 0; n < 4; ++n) { const bf16x8 kf = *(const LAS bf16x8*)(KL + (16 * n + fr) * 136 + ks * 32 + 8 * fq); s[n] = MFMA16(kf, qf[ks], s[n]); }
            const int dbase = (t0 + 16 * w + fr) - kt * 64 - 4 * fq;
            float mx = -1e30f;
            if (cq - kt >= 3) {
                const float bfar = BL[256];
#pragma unroll
                for (int n = 0; n < 4; ++n)
#pragma unroll
                    for (int e = 0; e < 4; ++e) { const float v = s[n][e] + bfar; s[n][e] = v; mx = fmaxf(mx, v); }
            } else {
#pragma unroll
                for (int n = 0; n < 4; ++n)
#pragma unroll
                    for (int e = 0; e < 4; ++e) { int d = dbase - 16 * n - e; d = d < -128 ? -128 : (d > 128 ? 128 : d); const float v = s[n][e] + BL[d + 128]; s[n][e] = v; mx = fmaxf(mx, v); }
            }
            mx = fmaxf(mx, __shfl_xor(mx, 16)); mx = fmaxf(mx, __shfl_xor(mx, 32));
            const float m_new = fmaxf(m_run, mx), alpha = __expf(m_run - m_new); float rs = 0.f;
#pragma unroll
            for (int n = 0; n < 4; ++n) { const float p0 = __expf(s[n][0] - m_new), p1 = __expf(s[n][1] - m_new), p2 = __expf(s[n][2] - m_new), p3 = __expf(s[n][3] - m_new);
                rs += (p0 + p1) + (p2 + p3); u32x2 pw; pw.x = pk2(p0, p1); pw.y = pk2(p2, p3);
                *(LAS u32x2*)(PL + (w * 16 + fr) * 72 + 16 * n + 4 * fq) = pw; }
            rs += __shfl_xor(rs, 16); rs += __shfl_xor(rs, 32);
            l_run = l_run * alpha + rs; m_run = m_new;
#pragma unroll
            for (int n = 0; n < 8; ++n) o[n] = o[n] * alpha;
            LDS_WAIT();
#pragma unroll
            for (int ks = 0; ks < 2; ++ks) { const bf16x8 pf = *(const LAS bf16x8*)(PL + (w * 16 + fr) * 72 + ks * 32 + 8 * fq);
#pragma unroll
                for (int n = 0; n < 8; ++n) { const bf16x8 vf = *(const LAS bf16x8*)(VL + (16 * n + fr) * 72 + ks * 32 + 8 * fq); o[n] = MFMA16(vf, pf, o[n]); } }
        }
    }
#undef ATT_PREFETCH
    const float inv = 64.0f / l_run; unsigned char* orow = (unsigned char*)YB + (size_t)(b * SEQ + t0 + 16 * w + fr) * 1024 + h * 128 + 4 * fq;
#pragma unroll
    for (int n = 0; n < 8; ++n) { int a = 0; a = __builtin_amdgcn_cvt_pk_fp8_f32(o[n][0] * inv, o[n][1] * inv, a, false); a = __builtin_amdgcn_cvt_pk_fp8_f32(o[n][2] * inv, o[n][3] * inv, a, true); *(GAS unsigned*)(orow + 16 * n) = (unsigned)a; }
}

DI void attn_unit2(Frame& F, int unit) {
    int tid = F.tid; asm volatile("" : "+v"(tid));
    const int cp4 = unit & 15, h = (unit >> 4) & 7, b = unit >> 7, lane = tid & 63, w = F.wave, fr = lane & 15, fq = lane >> 4;
    LAS bf16* KL = (LAS bf16*)(F.lds);
    LAS bf16* VL = KL + 64 * 136;
    LAS bf16* PL = VL + 128 * 72;
    LAS float* BL = (LAS float*)(PL + 8 * 32 * 72);
    const bf16* QK = (const bf16*)(F.ws + WS_S2); const bf16* VT = (const bf16*)(F.ws + WS_S6); bf16* YB = (bf16*)(F.ws + WS_S3 + 16 * MiB);
    const int t0 = cp4 * 256, cq = 4 * cp4 + (w >> 1);
    const int kt_lo = (4 * cp4 - 8) < 0 ? 0 : (4 * cp4 - 8), kt_hi = 4 * cp4 + 3;
    __syncthreads();
    for (int i = tid; i < 257; i += 512) BL[i] = F.in[I_RELB][h * 257 + i] * 1.4426950408889634f;
    bf16x8 qf[2][4];
#pragma unroll
    for (int r = 0; r < 2; ++r)
#pragma unroll
        for (int ks = 0; ks < 4; ++ks) qf[r][ks] = *(const GAS bf16x8*)(QK + (size_t)(b * SEQ + t0 + 32 * w + 16 * r + fr) * 2048 + h * 128 + ks * 32 + 8 * fq);
    v4u kreg[2][2], vreg[2][2];
#define ATT_PREFETCH(kt, S) do { _Pragma("unroll") for (int k = 0; k < 2; ++k) { const int id = tid + 512 * k; \
        kreg[S][k] = *(const GAS v4u*)(QK + (size_t)(b * SEQ + (kt) * 64 + (id >> 4)) * 2048 + 1024 + h * 128 + (id & 15) * 8); \
        vreg[S][k] = *(const GAS v4u*)(VT + (size_t)((b * 8 + h) * 128 + (id >> 3)) * 4096 + (kt) * 64 + (id & 7) * 8); } } while (0)
    ATT_PREFETCH(kt_lo, 0); ATT_PREFETCH(kt_lo + 1, 1);
    f32x4 o[2][8]; float m_run[2] = {-1e30f, -1e30f}, l_run[2] = {0.f, 0.f};
#pragma unroll
    for (int r = 0; r < 2; ++r)
#pragma unroll
        for (int n = 0; n < 8; ++n) o[r][n] = (f32x4){0.f, 0.f, 0.f, 0.f};
    for (int kt0 = kt_lo; kt0 <= kt_hi; kt0 += 2)
#pragma unroll
    for (int par = 0; par < 2; ++par) { const int kt = kt0 + par;
        LDS_WAIT(); __builtin_amdgcn_s_barrier(); asm volatile("" ::: "memory");
#pragma unroll
        for (int k = 0; k < 2; ++k) { const int id = tid + 512 * k; *(LAS v4u*)(KL + (id >> 4) * 136 + (id & 15) * 8) = kreg[par][k]; *(LAS v4u*)(VL + (id >> 3) * 72 + (id & 7) * 8) = vreg[par][k]; }
        LDS_WAIT(); __builtin_amdgcn_s_barrier(); asm volatile("" ::: "memory");
        if (kt + 2 <= kt_hi) ATT_PREFETCH(kt + 2, par);
        if (kt >= cq - 8 && kt <= cq) {
            f32x4 s[2][4];
#pragma unroll
            for (int r = 0; r < 2; ++r)
#pragma unroll
                for (int n = 0; n < 4; ++n) s[r][n] = (f32x4){0.f, 0.f, 0.f, 0.f};
#pragma unroll
            for (int ks = 0; ks < 4; ++ks)
#pragma unroll
                for (int n = 0; n < 4; ++n) { const bf16x8 kf = *(const LAS bf16x8*)(KL + (16 * n + fr) * 136 + ks * 32 + 8 * fq); s[0][n] = MFMA16(kf, qf[0][ks], s[0][n]); s[1][n] = MFMA16(kf, qf[1][ks], s[1][n]); }
            const bool far = cq - kt >= 3; const float bfar = BL[256];
#pragma unroll
            for (int r = 0; r < 2; ++r) {
                float mx, cadd;
                if (far) {
                    mx = fmaxf(fmaxf(fmaxf(fmaxf(s[r][0][0], s[r][0][1]), s[r][0][2]), fmaxf(fmaxf(s[r][0][3], s[r][1][0]), s[r][1][1])), fmaxf(fmaxf(fmaxf(s[r][1][2], s[r][1][3]), s[r][2][0]), fmaxf(fmaxf(s[r][2][1], s[r][2][2]), s[r][2][3])));
                    mx = fmaxf(fmaxf(mx, fmaxf(fmaxf(s[r][3][0], s[r][3][1]), s[r][3][2])), s[r][3][3]) + bfar;
                } else {
                    const int dbase = (t0 + 32 * w + 16 * r + fr) - kt * 64 - 4 * fq; mx = -1e30f;
#pragma unroll
                    for (int n = 0; n < 4; ++n)
#pragma unroll
                        for (int e = 0; e < 4; ++e) { int d = dbase - 16 * n - e; d = d < -128 ? -128 : (d > 128 ? 128 : d); const float v = s[r][n][e] + BL[d + 128]; s[r][n][e] = v; mx = fmaxf(mx, v); }
                }
                mx = fmaxf(mx, __shfl_xor(mx, 16)); mx = fmaxf(mx, __shfl_xor(mx, 32));
                const float m_new = fmaxf(m_run[r], mx), alpha = __builtin_amdgcn_exp2f(m_run[r] - m_new); float rs = 0.f;
                cadd = (far ? bfar : 0.f) - m_new;
#pragma unroll
                for (int n = 0; n < 4; ++n) { const float p0 = __builtin_amdgcn_exp2f(s[r][n][0] + cadd), p1 = __builtin_amdgcn_exp2f(s[r][n][1] + cadd), p2 = __builtin_amdgcn_exp2f(s[r][n][2] + cadd), p3 = __builtin_amdgcn_exp2f(s[r][n][3] + cadd);
                    rs += (p0 + p1) + (p2 + p3); u32x2 pw; pw.x = pk2(p0, p1); pw.y = pk2(p2, p3);
                    *(LAS u32x2*)(PL + (w * 32 + 16 * r + fr) * 72 + 16 * n + 4 * fq) = pw; }
                rs += __shfl_xor(rs, 16); rs += __shfl_xor(rs, 32);
                l_run[r] = l_run[r] * alpha + rs;
                if (__builtin_amdgcn_ballot_w64(m_new != m_run[r]) != 0ull) {
#pragma unroll
                    for (int n = 0; n < 8; ++n) o[r][n] = o[r][n] * alpha;
                }
                m_run[r] = m_new;
            }
            LDS_WAIT();
#pragma unroll
            for (int ks = 0; ks < 2; ++ks) { const bf16x8 pf0 = *(const LAS bf16x8*)(PL + (w * 32 + fr) * 72 + ks * 32 + 8 * fq), pf1 = *(const LAS bf16x8*)(PL + (w * 32 + 16 + fr) * 72 + ks * 32 + 8 * fq);
#pragma unroll
                for (int n = 0; n < 8; ++n) { const bf16x8 vf = *(const LAS bf16x8*)(VL + (16 * n + fr) * 72 + ks * 32 + 8 * fq); o[0][n] = MFMA16(vf, pf0, o[0][n]); o[1][n] = MFMA16(vf, pf1, o[1][n]); } }
        }
    }
#undef ATT_PREFETCH
#pragma unroll
    for (int r = 0; r < 2; ++r) { const float inv = 64.0f / l_run[r]; unsigned char* orow = (unsigned char*)YB + (size_t)(b * SEQ + t0 + 32 * w + 16 * r + fr) * 1024 + h * 128 + 4 * fq;
#pragma unroll
        for (int n = 0; n < 8; ++n) { int a = 0; a = __builtin_amdgcn_cvt_pk_fp8_f32(o[r][n][0] * inv, o[r][n][1] * inv, a, false); a = __builtin_amdgcn_cvt_pk_fp8_f32(o[r][n][2] * inv, o[r][n][3] * inv, a, true); *(GAS unsigned*)(orow + 16 * n) = (unsigned)a; } }
}

DI void score_unit(Frame& F, int unit) {
    const int p = unit & 1, h = (unit >> 1) & 7, tt = unit >> 4, lane = F.lane, w = F.wave, fr = lane & 15, fq = lane >> 4;
    const bf16* PQ = (const bf16*)(F.ws + WS_S0); const bf16* SK = (const bf16*)(F.ws + WS_SUBK) + (size_t)p * 128 * 128; float* SC = (float*)(F.ws + WS_S2);
    const int tok = tt * 128 + 16 * w + fr;
    f32x4 s[8];
#pragma unroll
    for (int n = 0; n < 8; ++n) s[n] = (f32x4){0.f, 0.f, 0.f, 0.f};
#pragma unroll
    for (int ks = 0; ks < 4; ++ks) { const bf16x8 af = *(const GAS bf16x8*)(PQ + (size_t)tok * 2048 + h * 256 + p * 128 + ks * 32 + 8 * fq);
#pragma unroll
        for (int n = 0; n < 8; ++n) { const bf16x8 kf = *(const GAS bf16x8*)(SK + (size_t)(16 * n + fr) * 128 + ks * 32 + 8 * fq); s[n] = MFMA16(kf, af, s[n]); } }
    const size_t v = (size_t)(h * 2 + p) * TOK + tok;
#pragma unroll
    for (int n = 0; n < 8; ++n) *(GAS f32x4*)(SC + ((size_t)(4 * n + fq) * (TOK * 16) + v) * 4) = s[n];
}

DI unsigned key_of(float v) { unsigned u = __builtin_bit_cast(unsigned, v); return u ^ ((unsigned)((int)u >> 31) | 0x80000000u); }
DI float val_of(unsigned k) { const unsigned u = (k & 0x80000000u) ? (k ^ 0x80000000u) : ~k; return __builtin_bit_cast(float, u); }
DI unsigned idx7(unsigned long long lo, unsigned long long hi, int i) { const bool first = i < 9; const unsigned long long w = first ? lo : hi; return (unsigned)(w >> (7 * (first ? i : i - 9))) & 127u; }
#define RB_CE(V, a, b) { const unsigned hi_ = V[a] > V[b] ? V[a] : V[b]; V[b] = V[a] > V[b] ? V[b] : V[a]; V[a] = hi_; }
#define RB_SORT16(V) do { RB_CE(V, 0, 1) RB_CE(V, 3, 2) RB_CE(V, 4, 5) RB_CE(V, 7, 6) RB_CE(V, 8, 9) RB_CE(V, 11, 10) RB_CE(V, 12, 13) RB_CE(V, 15, 14) RB_CE(V, 0, 2) RB_CE(V, 1, 3) RB_CE(V, 6, 4) RB_CE(V, 7, 5) RB_CE(V, 8, 10) RB_CE(V, 9, 11) RB_CE(V, 14, 12) RB_CE(V, 15, 13) RB_CE(V, 0, 1) RB_CE(V, 2, 3) RB_CE(V, 5, 4) RB_CE(V, 7, 6) RB_CE(V, 8, 9) RB_CE(V, 10, 11) RB_CE(V, 13, 12) RB_CE(V, 15, 14) RB_CE(V, 0, 4) RB_CE(V, 1, 5) RB_CE(V, 2, 6) RB_CE(V, 3, 7) RB_CE(V, 12, 8) RB_CE(V, 13, 9) RB_CE(V, 14, 10) RB_CE(V, 15, 11) RB_CE(V, 0, 2) RB_CE(V, 1, 3) RB_CE(V, 4, 6) RB_CE(V, 5, 7) RB_CE(V, 10, 8) RB_CE(V, 11, 9) RB_CE(V, 14, 12) RB_CE(V, 15, 13) RB_CE(V, 0, 1) RB_CE(V, 2, 3) RB_CE(V, 4, 5) RB_CE(V, 6, 7) RB_CE(V, 9, 8) RB_CE(V, 11, 10) RB_CE(V, 13, 12) RB_CE(V, 15, 14) RB_CE(V, 0, 8) RB_CE(V, 1, 9) RB_CE(V, 2, 10) RB_CE(V, 3, 11) RB_CE(V, 4, 12) RB_CE(V, 5, 13) RB_CE(V, 6, 14) RB_CE(V, 7, 15) RB_CE(V, 0, 4) RB_CE(V, 1, 5) RB_CE(V, 2, 6) RB_CE(V, 3, 7) RB_CE(V, 8, 12) RB_CE(V, 9, 13) RB_CE(V, 10, 14) RB_CE(V, 11, 15) RB_CE(V, 0, 2) RB_CE(V, 1, 3) RB_CE(V, 4, 6) RB_CE(V, 5, 7) RB_CE(V, 8, 10) RB_CE(V, 9, 11) RB_CE(V, 12, 14) RB_CE(V, 13, 15) RB_CE(V, 0, 1) RB_CE(V, 2, 3) RB_CE(V, 4, 5) RB_CE(V, 6, 7) RB_CE(V, 8, 9) RB_CE(V, 10, 11) RB_CE(V, 12, 13) RB_CE(V, 14, 15) } while (0)
#define RB_MERGE16(V) do { RB_CE(V, 0, 8) RB_CE(V, 1, 9) RB_CE(V, 2, 10) RB_CE(V, 3, 11) RB_CE(V, 4, 12) RB_CE(V, 5, 13) RB_CE(V, 6, 14) RB_CE(V, 7, 15) RB_CE(V, 0, 4) RB_CE(V, 1, 5) RB_CE(V, 2, 6) RB_CE(V, 3, 7) RB_CE(V, 8, 12) RB_CE(V, 9, 13) RB_CE(V, 10, 14) RB_CE(V, 11, 15) RB_CE(V, 0, 2) RB_CE(V, 1, 3) RB_CE(V, 4, 6) RB_CE(V, 5, 7) RB_CE(V, 8, 10) RB_CE(V, 9, 11) RB_CE(V, 12, 14) RB_CE(V, 13, 15) RB_CE(V, 0, 1) RB_CE(V, 2, 3) RB_CE(V, 4, 5) RB_CE(V, 6, 7) RB_CE(V, 8, 9) RB_CE(V, 10, 11) RB_CE(V, 12, 13) RB_CE(V, 14, 15) } while (0)
DI void route_block(Frame& F, int ib) {
    const int lane = F.lane, hh = ib >> 8, t0 = (ib & 255) * 32, p = lane >> 5, t = t0 + (lane & 31);
    const float* SC = (const float*)(F.ws + WS_S2);
    const size_t v = (size_t)(hh * 2 + p) * TOK + t;
    unsigned A[16];
#pragma unroll 1
    for (int g = 0; g < 8; ++g) {
        unsigned N[16];
#pragma unroll
        for (int c = 0; c < 2; ++c) { const v4u sw = *(const GAS v4u*)((const unsigned char*)SC + ((size_t)(2 * g + c) * (TOK * 16) + v) * 16);
            typedef _Float16 h2_ __attribute__((ext_vector_type(2))); const unsigned w4[4] = {sw.x, sw.y, sw.z, sw.w};
#pragma unroll
            for (int e = 0; e < 4; ++e) { const h2_ hp = __builtin_bit_cast(h2_, w4[e]);
                N[8 * c + 2 * e] = (key_of((float)hp.x) & ~127u) | (unsigned)(16 * g + 8 * c + 2 * e); N[8 * c + 2 * e + 1] = (key_of((float)hp.y) & ~127u) | (unsigned)(16 * g + 8 * c + 2 * e + 1); } }
        RB_SORT16(N);
        if (g == 0) {
#pragma unroll
            for (int k = 0; k < 16; ++k) A[k] = N[k];
        } else {
#pragma unroll
            for (int k = 0; k < 16; ++k) A[k] = A[k] > N[15 - k] ? A[k] : N[15 - k];
            RB_MERGE16(A);
        }
    }
    unsigned B[16];
#pragma unroll
    for (int k = 0; k < 16; ++k) B[k] = (unsigned)__shfl((int)A[k], (lane & 31) + 32);
    float va[16], vb[16]; unsigned long long alo = 0, ahi = 0, blo = 0, bhi = 0;
#pragma unroll
    for (int k = 0; k < 16; ++k) { va[k] = val_of(A[k] & ~127u); vb[k] = val_of(B[k] & ~127u);
        if (k < 9) { alo |= (unsigned long long)(A[k] & 127u) << (7 * k); blo |= (unsigned long long)(B[k] & 127u) << (7 * k); }
        else { ahi |= (unsigned long long)(A[k] & 127u) << (7 * (k - 9)); bhi |= (unsigned long long)(B[k] & 127u) << (7 * (k - 9)); } }
    unsigned C[16];
#pragma unroll
    for (int k = 0; k < 16; ++k) C[k] = 0u;
#pragma unroll
    for (int i = 0; i < 16; ++i)
#pragma unroll
        for (int j = 0; j < 16; ++j) if ((i + 1) * (j + 1) <= 16) { unsigned x = (key_of(va[i] + vb[j]) & ~255u) | (unsigned)(i * 16 + j);
#pragma unroll
            for (int k = (i + 1) * (j + 1) - 1; k < 16; ++k) { const unsigned hi_ = C[k] > x ? C[k] : x; x = C[k] > x ? x : C[k]; C[k] = hi_; } }
    float ev[16]; int ex[16]; float sum = 0.f; const float top = val_of(C[0] & ~255u);
#pragma unroll
    for (int r = 0; r < 16; ++r) { const int ij = (int)(C[r] & 255u); ev[r] = __expf(val_of(C[r] & ~255u) - top); sum += ev[r];
        ex[r] = (int)(idx7(alo, ahi, ij >> 4) * 128u + idx7(blo, bhi, ij & 15)); }
    const float inv = 1.0f / sum;
    if (lane < 32) {
        int* EI = (int*)(F.ws + WS_S4) + ((size_t)t * 8 + hh) * 16; float* EG = (float*)(F.ws + WS_S4 + 4 * MiB) + ((size_t)t * 8 + hh) * 16;
#pragma unroll
        for (int r = 0; r < 16; r += 4) { *(GAS v4u*)(EI + r) = (v4u){(unsigned)ex[r], (unsigned)ex[r + 1], (unsigned)ex[r + 2], (unsigned)ex[r + 3]};
            *(GAS f32x4*)(EG + r) = (f32x4){ev[r] * inv, ev[r + 1] * inv, ev[r + 2] * inv, ev[r + 3] * inv}; }
    }
}

typedef float f32x2p __attribute__((ext_vector_type(2)));
typedef __bf16 bf16x2p __attribute__((ext_vector_type(2)));
struct PeerTok { unsigned xn[16]; f32x2p acc[16]; int e_lo, e_hi; float g_lo, g_hi; };
DI void peer_open(Frame& F, PeerTok& T, int t, LAS unsigned* wl) {
    const int lane = F.lane; int l32 = 4 * F.lane; asm volatile("" : "+v"(l32));
    const bf16* Hrow = (const bf16*)(F.ws + WS_S6) + (size_t)t * DM;
    f32x4 hv[8]; float ss = 0.f;
#pragma unroll
    for (int k = 0; k < 8; ++k) { const u32x2 hw = *(const GAS u32x2*)(Hrow + l32 + 256 * k); hv[k] = (f32x4){bflo(hw.x), bfhi(hw.x), bflo(hw.y), bfhi(hw.y)}; const f32x4 a = hv[k]; ss += (a.x * a.x + a.y * a.y) + (a.z * a.z + a.w * a.w); }
    const float rstd = 1.0f / sqrtf(wave_sum(ss) * (1.f / DM) + EPS);
#pragma unroll
    for (int k = 0; k < 8; ++k) { const f32x4 g = *(const GAS f32x4*)(F.in[I_GFFN] + l32 + 256 * k); const f32x4 a = hv[k];
        T.xn[2 * k] = pk2(a.x * rstd * g.x, a.y * rstd * g.y); T.xn[2 * k + 1] = pk2(a.z * rstd * g.z, a.w * rstd * g.w); }
#pragma unroll
    for (int i = 0; i < 16; ++i) T.acc[i] = (f32x2p){0.f, 0.f};
    const int* EI = (const int*)(F.ws + WS_S4) + (size_t)t * 128; const float* EG = (const float*)(F.ws + WS_S4 + 4 * MiB) + (size_t)t * 128;
    const int e0 = EI[lane], e1 = EI[64 + lane]; const float g0 = EG[lane], g1 = EG[64 + lane];
    wl[lane] = 0u; wl[64 + lane] = 0u; LDS_WAIT();
    const unsigned o0 = __hip_atomic_fetch_add(wl + (e0 >> 7), 1u, __ATOMIC_RELAXED, __HIP_MEMORY_SCOPE_WAVEFRONT);
    const unsigned o1 = __hip_atomic_fetch_add(wl + (e1 >> 7), 1u, __ATOMIC_RELAXED, __HIP_MEMORY_SCOPE_WAVEFRONT);
    LDS_WAIT();
    const int c0 = (int)wl[lane], c1 = (int)wl[64 + lane];
    int i0 = c0, i1 = c1;
#pragma unroll
    for (int o = 1; o < 64; o <<= 1) { const int t0 = __shfl_up(i0, o), t1 = __shfl_up(i1, o); if (lane >= o) { i0 += t0; i1 += t1; } }
    const int tot0 = __shfl(i0, 63);
    wl[128 + lane] = (unsigned)(i0 - c0); wl[192 + lane] = (unsigned)(tot0 + i1 - c1); LDS_WAIT();
    const unsigned p0 = wl[128 + (e0 >> 7)] + o0, p1 = wl[128 + (e1 >> 7)] + o1; LDS_WAIT();
    wl[256 + 2 * p0] = (unsigned)e0; wl[256 + 2 * p0 + 1] = __builtin_bit_cast(unsigned, g0); wl[256 + 2 * p1] = (unsigned)e1; wl[256 + 2 * p1 + 1] = __builtin_bit_cast(unsigned, g1); LDS_WAIT();
    T.e_lo = (int)wl[256 + 2 * lane]; T.g_lo = __builtin_bit_cast(float, wl[256 + 2 * lane + 1]); T.e_hi = (int)wl[256 + 2 * (64 + lane)]; T.g_hi = __builtin_bit_cast(float, wl[256 + 2 * (64 + lane) + 1]); LDS_WAIT();
}
DI void peer_close(Frame& F, PeerTok& T, int t) {
    int l16 = 4 * F.lane; asm volatile("" : "+v"(l16));
    const bf16* Hrow = (const bf16*)(F.ws + WS_S6) + (size_t)t * DM;
    float s3 = 0.f;
#pragma unroll
    for (int k = 0; k < 8; ++k) { const u32x2 hw = *(const GAS u32x2*)(Hrow + l16 + 256 * k); const f32x4 a = (f32x4){bflo(hw.x), bfhi(hw.x), bflo(hw.y), bfhi(hw.y)};
        T.acc[2 * k] += (f32x2p){a.x, a.y}; T.acc[2 * k + 1] += (f32x2p){a.z, a.w};
        s3 += (T.acc[2 * k].x * T.acc[2 * k].x + T.acc[2 * k].y * T.acc[2 * k].y) + (T.acc[2 * k + 1].x * T.acc[2 * k + 1].x + T.acc[2 * k + 1].y * T.acc[2 * k + 1].y); }
    const float r3 = 1.0f / sqrtf(wave_sum(s3) * (1.f / DM) + EPS);
    float* orow = F.out + (size_t)t * DM;
#pragma unroll
    for (int k = 0; k < 8; ++k) { const f32x4 g = *(const GAS f32x4*)(F.in[I_GFIN] + l16 + 256 * k);
        *(GAS f32x4*)(orow + l16 + 256 * k) = (f32x4){T.acc[2 * k].x * r3 * g.x, T.acc[2 * k].y * r3 * g.y, T.acc[2 * k + 1].x * r3 * g.z, T.acc[2 * k + 1].y * r3 * g.w}; }
}
template <bool DESC> DI void peer_pair(Frame& F, int tA, int tB) {
    const int lane = F.lane;
    const unsigned char* PU4 = F.ws + WS_PU; const unsigned char* PV4 = F.ws + WS_PU + 16 * MiB; const float* FS = (const float*)(F.ws + WS_PU + 64 * MiB);
    LAS unsigned* wl = (LAS unsigned*)(F.lds + F.wave * 2048);
    PeerTok A, B;
    peer_open(F, A, tA, wl); peer_open(F, B, tB, wl);
#if defined(DBG_STAMP)
    constexpr int PG = (DBG_STAMP >= 0) ? 2 : 4;
#else
    constexpr int PG = 4;
#endif
    v4u ua[PG], ub[PG], vv[PG];
#define PEER_EX(T, k) __builtin_amdgcn_readlane((k) < 64 ? T.e_lo : T.e_hi, (k) & 63)
#define PEER_LOADU(T, dst, k0) do { _Pragma("unroll") for (int q = 0; q < PG; ++q) { const int e = PEER_EX(T, (k0) + q); dst[q] = *(const GAS v4u*)(PU4 + (size_t)e * 1024 + 16 * lane); } } while (0)
#define PEER_GROUP(T, ucur, k0) do { \
        int ex[PG]; float gt[PG]; \
        _Pragma("unroll") for (int q = 0; q < PG; ++q) { ex[q] = PEER_EX(T, (k0) + q); gt[q] = __builtin_bit_cast(float, __builtin_amdgcn_readlane(__builtin_bit_cast(int, (k0) < 64 ? T.g_lo : T.g_hi), ((k0) + q) & 63)); \
            vv[q] = *(const GAS v4u*)(PV4 + (size_t)ex[q] * 1024 + 16 * lane); } \
        float act[PG]; \
        _Pragma("unroll") for (int q = 0; q < PG; ++q) { float d = 0.f; const v4u u = ucur[q]; const unsigned w4[4] = {u.x, u.y, u.z, u.w}; \
            _Pragma("unroll") for (int c = 0; c < 4; ++c) { \
                d = __builtin_amdgcn_fdot2_f32_bf16(__builtin_amdgcn_cvt_scalef32_pk_bf16_fp4(w4[c], 1.0f, 0), __builtin_bit_cast(bf16x2p, T.xn[4 * c + 0]), d, false); \
                d = __builtin_amdgcn_fdot2_f32_bf16(__builtin_amdgcn_cvt_scalef32_pk_bf16_fp4(w4[c], 1.0f, 1), __builtin_bit_cast(bf16x2p, T.xn[4 * c + 1]), d, false); \
                d = __builtin_amdgcn_fdot2_f32_bf16(__builtin_amdgcn_cvt_scalef32_pk_bf16_fp4(w4[c], 1.0f, 2), __builtin_bit_cast(bf16x2p, T.xn[4 * c + 2]), d, false); \
                d = __builtin_amdgcn_fdot2_f32_bf16(__builtin_amdgcn_cvt_scalef32_pk_bf16_fp4(w4[c], 1.0f, 3), __builtin_bit_cast(bf16x2p, T.xn[4 * c + 3]), d, false); } \
            act[q] = d; __builtin_amdgcn_sched_barrier(0); } \
        if (DESC ? (k0) - PG >= 0 : (k0) + PG < 128) PEER_LOADU(T, ucur, DESC ? (k0) - PG : (k0) + PG); \
        _Pragma("unroll") for (int o = 1; o < 64; o <<= 1) { _Pragma("unroll") for (int q = 0; q < PG; ++q) act[q] += __shfl_xor(act[q], o); } \
        _Pragma("unroll") for (int q = 0; q < PG; ++q) { const float a = gelu1(act[q] * FS[ex[q]]) * gt[q] * FS[16384 + ex[q]]; const f32x2p a2 = (f32x2p){a, a}; \
            const v4u v = vv[q]; const unsigned w4[4] = {v.x, v.y, v.z, v.w}; \
            _Pragma("unroll") for (int c = 0; c < 4; ++c) { T.acc[4 * c + 0] += a2 * __builtin_amdgcn_cvt_scalef32_pk_f32_fp4(w4[c], 1.0f, 0); T.acc[4 * c + 1] += a2 * __builtin_amdgcn_cvt_scalef32_pk_f32_fp4(w4[c], 1.0f, 1); \
                T.acc[4 * c + 2] += a2 * __builtin_amdgcn_cvt_scalef32_pk_f32_fp4(w4[c], 1.0f, 2); T.acc[4 * c + 3] += a2 * __builtin_amdgcn_cvt_scalef32_pk_f32_fp4(w4[c], 1.0f, 3); } __builtin_amdgcn_sched_barrier(0); } \
    } while (0)
    if (DESC) { PEER_LOADU(A, ua, 128 - PG); PEER_LOADU(B, ub, 128 - PG); for (int k0 = 128 - PG; k0 >= 0; k0 -= PG) { PEER_GROUP(A, ua, k0); PEER_GROUP(B, ub, k0); } }
    else { PEER_LOADU(A, ua, 0); PEER_LOADU(B, ub, 0); for (int k0 = 0; k0 < 128; k0 += PG) { PEER_GROUP(A, ua, k0); PEER_GROUP(B, ub, k0); } }
#undef PEER_GROUP
#undef PEER_LOADU
#undef PEER_EX
    peer_close(F, A, tA); peer_close(F, B, tB);
}

typedef int v8i __attribute__((ext_vector_type(8)));
typedef unsigned v8u __attribute__((ext_vector_type(8)));
#ifndef P3_SELFTEST
#define P3_SELFTEST 0
#endif
#ifndef P3_PROBE_P
#define P3_PROBE_P 32
#endif
constexpr int P3_SLICE = 16640, P3_ROWS = 8192, P3_RSTR = 1040;
DI void peer_open3(Frame& F, int t, int ti, LAS unsigned char* slice, f32x2p* acc) {
    int lane = F.lane; asm volatile("" : "+v"(lane)); const int l32 = 4 * lane;
    const bf16* Arow = (const bf16*)(F.ws + WS_S0) + (size_t)t * DM; const float* FS = (const float*)(F.ws + WS_PU + 64 * MiB);
    f32x4 av[8]; float ss = 0.f;
#pragma unroll
    for (int k = 0; k < 8; ++k) { const u32x2 hw = *(const GAS u32x2*)(Arow + l32 + 256 * k); av[k] = (f32x4){bflo(hw.x), bfhi(hw.x), bflo(hw.y), bfhi(hw.y)}; const f32x4 g = *(const GAS f32x4*)(F.in[I_GFFN] + l32 + 256 * k);
        const f32x4 a = (f32x4){av[k].x * __builtin_amdgcn_rcpf(g.x), av[k].y * __builtin_amdgcn_rcpf(g.y), av[k].z * __builtin_amdgcn_rcpf(g.z), av[k].w * __builtin_amdgcn_rcpf(g.w)};
        acc[2 * k] = (f32x2p){a.x, a.y}; acc[2 * k + 1] = (f32x2p){a.z, a.w}; ss += (a.x * a.x + a.y * a.y) + (a.z * a.z + a.w * a.w); }
    const float r16 = 16.0f / sqrtf(wave_sum(ss) * (1.f / DM) + EPS);
    unsigned w8[8];
#pragma unroll
    for (int k = 0; k < 8; ++k) { const f32x4 a = av[k]; int p = 0;
        p = __builtin_amdgcn_cvt_pk_fp8_f32(a.x * r16, a.y * r16, p, false); p = __builtin_amdgcn_cvt_pk_fp8_f32(a.z * r16, a.w * r16, p, true); w8[k] = (unsigned)p; }
    *(LAS v4u*)(slice + ti * 2048 + lane * 32) = (v4u){w8[0], w8[1], w8[2], w8[3]}; *(LAS v4u*)(slice + ti * 2048 + lane * 32 + 16) = (v4u){w8[4], w8[5], w8[6], w8[7]};
    LAS unsigned* wl = (LAS unsigned*)(slice + 7168);
    LAS unsigned* E = (LAS unsigned*)(slice + 4096 + ti * 1536); LAS float* SU = (LAS float*)(E + 128); LAS float* GV = SU + 128;
    const int* EI = (const int*)(F.ws + WS_S4) + (size_t)t * 128; const float* EG = (const float*)(F.ws + WS_S4 + 4 * MiB) + (size_t)t * 128;
    const int e0 = EI[lane], e1 = EI[64 + lane]; const float g0 = EG[lane], g1 = EG[64 + lane];
    const float su0 = FS[e0] * 0.0625f, su1 = FS[e1] * 0.0625f, gv0 = g0 * FS[16384 + e0], gv1 = g1 * FS[16384 + e1];
    wl[lane] = 0u; wl[64 + lane] = 0u; LDS_WAIT();
    const unsigned o0 = __hip_atomic_fetch_add(wl + (e0 >> 7), 1u, __ATOMIC_RELAXED, __HIP_MEMORY_SCOPE_WAVEFRONT);
    const unsigned o1 = __hip_atomic_fetch_add(wl + (e1 >> 7), 1u, __ATOMIC_RELAXED, __HIP_MEMORY_SCOPE_WAVEFRONT);
    LDS_WAIT();
    const int c0 = (int)wl[lane], c1 = (int)wl[64 + lane];
    int i0 = c0, i1 = c1;
#pragma unroll
    for (int o = 1; o < 64; o <<= 1) { const int t0 = __shfl_up(i0, o), t1 = __shfl_up(i1, o); if (lane >= o) { i0 += t0; i1 += t1; } }
    const int tot0 = __shfl(i0, 63);
    wl[128 + lane] = (unsigned)(i0 - c0); wl[192 + lane] = (unsigned)(tot0 + i1 - c1); LDS_WAIT();
    const unsigned p0 = wl[128 + (e0 >> 7)] + o0, p1 = wl[128 + (e1 >> 7)] + o1; LDS_WAIT();
    E[p0] = (unsigned)e0; SU[p0] = su0; GV[p0] = gv0; E[p1] = (unsigned)e1; SU[p1] = su1; GV[p1] = gv1; LDS_WAIT();
}
DI void peer_close3(Frame& F, f32x2p* acc, int t) {
    int l16 = 4 * F.lane; asm volatile("" : "+v"(l16));
    float s3 = 0.f;
#pragma unroll
    for (int k = 0; k < 8; ++k) s3 += (acc[2 * k].x * acc[2 * k].x + acc[2 * k].y * acc[2 * k].y) + (acc[2 * k + 1].x * acc[2 * k + 1].x + acc[2 * k + 1].y * acc[2 * k + 1].y);
    const float r3 = 1.0f / sqrtf(wave_sum(s3) * (1.f / DM) + EPS);
    float* orow = F.out + (size_t)t * DM;
#pragma unroll
    for (int k = 0; k < 8; ++k) { const f32x4 g = *(const GAS f32x4*)(F.in[I_GFIN] + l16 + 256 * k);
        __builtin_nontemporal_store((f32x4){acc[2 * k].x * r3 * g.x, acc[2 * k].y * r3 * g.y, acc[2 * k + 1].x * r3 * g.z, acc[2 * k + 1].y * r3 * g.w}, (GAS f32x4*)(orow + l16 + 256 * k)); }
}
template <bool DESC> DI void peer_pair3(Frame& F, int tA, int tB) {
    int lane = F.lane; asm volatile("" : "+v"(lane));
    const int kq = lane >> 4;
    const unsigned char* PU4 = F.ws + WS_PU; const unsigned char* PV4 = F.ws + WS_PU + 16 * MiB;
    LAS unsigned char* slice = F.lds + F.wave * P3_SLICE;
    f32x2p accA[16], accB[16];
    peer_open3(F, tA, 0, slice, accA); peer_open3(F, tB, 1, slice, accB);
    const LAS unsigned* Eb = (const LAS unsigned*)(slice + 4096 + ((lane >> 2) & 1) * 1536) + (lane & 3);
    const LAS float* SUl = (const LAS float*)(slice + 4096 + (kq & 1) * 1536 + 512);
    const LAS float* GVl = SUl + 128;
    const LAS unsigned char* arow = slice + P3_ROWS + (lane & 7) * P3_RSTR + kq * 16;
    const LAS unsigned char* xb = slice + (lane & 1) * 2048 + (kq >> 1) * 32 + (kq & 1) * 16;
    v4u v0[8], v1[8]; float diag = 0.f; unsigned unit_sc = 0x7F7F7F7Fu; asm volatile("" : "+v"(unit_sc));
#define P3_B(i) (DESC ? 31 - (i) : (i))
#define P3_ISSUE_A(EV) do { _Pragma("unroll") for (int j = 0; j < 8; ++j) { const unsigned e_ = (unsigned)__builtin_amdgcn_readlane((int)(EV), j); \
        __builtin_amdgcn_global_load_lds((const unsigned*)(PU4 + (size_t)e_ * 1024 + 16 * lane), (LAS unsigned*)(slice + P3_ROWS + j * P3_RSTR), 16, 0, 0); } } while (0)
#define P3_ISSUE_V(V, EV) do { _Pragma("unroll") for (int j = 0; j < 8; ++j) { const unsigned e_ = (unsigned)__builtin_amdgcn_readlane((int)(EV), j); V[j] = *(const GAS v4u*)(PV4 + (size_t)e_ * 1024 + 16 * lane); } } while (0)
#define P3_BATCH(i, VC, VN) do { \
        const int b_ = P3_B(i), bn_ = P3_B((i) + 1 < 32 ? (i) + 1 : (i)); \
        const f32x4 su = *(const LAS f32x4*)(SUl + 4 * b_), gv = *(const LAS f32x4*)(GVl + 4 * b_); const unsigned evn = Eb[4 * bn_]; \
        asm volatile("s_waitcnt vmcnt(8)" ::: "memory"); \
        f32x4 D = {0.f, 0.f, 0.f, 0.f}; asm volatile("s_nop 3" : "+v"(D)); \
        _Pragma("unroll") for (int s = 0; s < 16; ++s) { const v4u a_ = *(const LAS v4u*)(arow + 64 * s); const v4u b0 = *(const LAS v4u*)(xb + 128 * s), b1 = *(const LAS v4u*)(xb + 128 * s + 64); \
            const v8u b_ = (v8u){b0.x, b0.y, b0.z, b0.w, b1.x, b1.y, b1.z, b1.w}; asm volatile("v_mfma_scale_f32_16x16x128_f8f6f4 %0, %1, %2, %0, %3, %3 op_sel_hi:[0,0,0] cbsz:4" : "+v"(D) : "v"(a_), "v"(b_), "v"(unit_sc)); } \
        asm volatile("s_nop 15\n\ts_nop 15" : "+v"(D)); \
        float ac[4]; \
        _Pragma("unroll") for (int q = 0; q < 4; ++q) ac[q] = gelu1(D[q] * su[q]) * gv[q]; \
        LDS_WAIT(); \
        P3_ISSUE_A(evn); P3_ISSUE_V(VN, evn); \
        _Pragma("unroll") for (int j = 0; j < 8; ++j) { const float a = __builtin_bit_cast(float, __builtin_amdgcn_readlane(__builtin_bit_cast(int, ac[j & 3]), 17 * (j >> 2))); const f32x2p a2 = (f32x2p){a, a}; \
            const v4u v = VC[j]; const unsigned w4[4] = {v.x, v.y, v.z, v.w}; \
            _Pragma("unroll") for (int c = 0; c < 4; ++c) { \
                if (j < 4) { accA[4 * c + 0] += a2 * __builtin_amdgcn_cvt_scalef32_pk_f32_fp4(w4[c], 1.0f, 0); accA[4 * c + 1] += a2 * __builtin_amdgcn_cvt_scalef32_pk_f32_fp4(w4[c], 1.0f, 1); \
                    accA[4 * c + 2] += a2 * __builtin_amdgcn_cvt_scalef32_pk_f32_fp4(w4[c], 1.0f, 2); accA[4 * c + 3] += a2 * __builtin_amdgcn_cvt_scalef32_pk_f32_fp4(w4[c], 1.0f, 3); } \
                else { accB[4 * c + 0] += a2 * __builtin_amdgcn_cvt_scalef32_pk_f32_fp4(w4[c], 1.0f, 0); accB[4 * c + 1] += a2 * __builtin_amdgcn_cvt_scalef32_pk_f32_fp4(w4[c], 1.0f, 1); \
                    accB[4 * c + 2] += a2 * __builtin_amdgcn_cvt_scalef32_pk_f32_fp4(w4[c], 1.0f, 2); accB[4 * c + 3] += a2 * __builtin_amdgcn_cvt_scalef32_pk_f32_fp4(w4[c], 1.0f, 3); } } } \
    } while (0)
    { const unsigned ev = Eb[4 * P3_B(0)]; P3_ISSUE_A(ev); P3_ISSUE_V(v0, ev); }
        if (P3_SELFTEST) { if (!DESC && blockIdx.x == 0 && F.wave == 0) {
            asm volatile("s_waitcnt vmcnt(0)" ::: "memory");
            unsigned B1[8], B2[8];
#pragma unroll
            for (int w = 0; w < 8; ++w) { const int id0 = kq * 32 + 4 * w; int p1 = 0, p2 = 0;
                p1 = __builtin_amdgcn_cvt_pk_fp8_f32((float)((id0 + 0) & 7), (float)((id0 + 1) & 7), p1, false); p1 = __builtin_amdgcn_cvt_pk_fp8_f32((float)((id0 + 2) & 7), (float)((id0 + 3) & 7), p1, true);
                p2 = __builtin_amdgcn_cvt_pk_fp8_f32((float)((id0 + 0) >> 3), (float)((id0 + 1) >> 3), p2, false); p2 = __builtin_amdgcn_cvt_pk_fp8_f32((float)((id0 + 2) >> 3), (float)((id0 + 3) >> 3), p2, true);
                B1[w] = (unsigned)p1; B2[w] = (unsigned)p2; }
            const v8u b1_ = (v8u){B1[0], B1[1], B1[2], B1[3], B1[4], B1[5], B1[6], B1[7]}, b2_ = (v8u){B2[0], B2[1], B2[2], B2[3], B2[4], B2[5], B2[6], B2[7]};
            int c1 = 0, c2 = 0, c3 = 0, c4 = 0, c5 = 0, c6 = 0, id01 = 0, idq = 0;
#pragma nounroll
            for (int p = 0; p < 128; ++p) { const int g0 = p >> 5, n0 = p & 31;
                const unsigned hot = (lane == 16 * g0) ? (0x2u << (4 * (n0 & 7))) : 0u; const int wsel = n0 >> 3;
                v4u a_ = (v4u){wsel == 0 ? hot : 0u, wsel == 1 ? hot : 0u, wsel == 2 ? hot : 0u, wsel == 3 ? hot : 0u};
                f32x4 D1 = {0.f, 0.f, 0.f, 0.f}, D2 = {0.f, 0.f, 0.f, 0.f}; asm volatile("s_nop 15\n\ts_nop 15" : "+v"(D1), "+v"(D2), "+v"(a_));
                asm volatile("v_mfma_scale_f32_16x16x128_f8f6f4 %0, %1, %2, %0, %3, %3 op_sel_hi:[0,0,0] cbsz:4" : "+v"(D1) : "v"(a_), "v"(b1_), "v"(unit_sc));
                asm volatile("v_mfma_scale_f32_16x16x128_f8f6f4 %0, %1, %2, %0, %3, %3 op_sel_hi:[0,0,0] cbsz:4" : "+v"(D2) : "v"(a_), "v"(b2_), "v"(unit_sc));
                asm volatile("s_nop 15\n\ts_nop 15\n\ts_nop 15" : "+v"(D1), "+v"(D2));
                const int idp = (int)__builtin_bit_cast(float, __builtin_amdgcn_readlane(__builtin_bit_cast(int, D2[0]), 0)) * 8 + (int)__builtin_bit_cast(float, __builtin_amdgcn_readlane(__builtin_bit_cast(int, D1[0]), 0));
                const int kA0 = 32 * g0 + n0, kA1 = 32 * g0 + (n0 ^ 1), kA2 = 64 * (n0 >> 4) + 16 * g0 + (n0 & 15), kA3 = 64 * (n0 >> 4) + 16 * g0 + ((n0 ^ 1) & 15);
                const int ib0 = ((kA0 >> 4) & 3) * 32 + 16 * (kA0 >> 6) + (kA0 & 15), ib1 = ((kA1 >> 4) & 3) * 32 + 16 * (kA1 >> 6) + (kA1 & 15);
                c1 += (idp == ib0); c2 += (idp == ib1); c3 += (idp == kA2); c4 += (idp == kA3); c5 += (idp == kA0); c6 += (idp == kA1);
                if (p == 1) id01 = idp; if (p == P3_PROBE_P) idq = idp; }
            const int cf = c1 == 128 ? 1 : c2 == 128 ? 2 : c3 == 128 ? 3 : c4 == 128 ? 4 : c5 == 128 ? 5 : c6 == 128 ? 6 : 0;
            diag = (float)(20 + 2 * (P3_SELFTEST == 1 ? (cf ? cf : 7 + (id01 & 31)) : P3_SELFTEST == 2 ? (c5 >> 2) : P3_SELFTEST == 3 ? (idq >> 2) : (idq & 31))); } }
    for (int i = 0; i < 32; i += 2) { P3_BATCH(i, v0, v1); P3_BATCH(i + 1, v1, v0); }
    asm volatile("s_waitcnt vmcnt(0)" ::: "memory");
#undef P3_BATCH
#undef P3_ISSUE_V
#undef P3_ISSUE_A
#undef P3_B
    peer_close3(F, accA, tA); peer_close3(F, accB, tB);
    if (P3_SELFTEST) { if (!DESC && blockIdx.x == 0 && F.wave == 0 && lane == 0) { asm volatile("s_waitcnt vmcnt(0)" ::: "memory"); for (int c = 0; c < DM; ++c) F.out[(size_t)tA * DM + c] = diag; } }
}

struct Args { const float* in[23]; float* out; unsigned char* ws; int ph_lo, ph_hi, li, pad; };
__global__ void __launch_bounds__(NWAVES * 64, 2) mk_fwd(Args args) {
    extern __shared__ __attribute__((aligned(16))) unsigned char lds[];
    Frame F;
    F.lds = (LAS unsigned char*)lds;
    F.MISC = (volatile LAS unsigned*)(F.lds + MISC_OFF);
    F.tid = threadIdx.x; F.lane = F.tid & 63; F.wave = __builtin_amdgcn_readfirstlane(F.tid >> 6);
    F.G = gridDim.x; { const int bx = blockIdx.x; F.vcu = (F.G % 8 == 0) ? (bx % 8) * (F.G / 8) + bx / 8 : bx; }
#pragma unroll
    for (int i = 0; i < 23; ++i) F.in[i] = args.in[i];
    F.out = args.out; F.ws = args.ws; unsigned char* ws = args.ws;
    F.ctl = (gu32*)(ws + WS_CTL);
    for (int u = F.tid; u < (LDS_BYTES - LDSCTL_OFF) / 4; u += NWAVES * 64) ((LAS unsigned*)(F.lds + LDSCTL_OFF))[u] = 0u;
    __syncthreads();
#ifndef DBG_STAMP
#define DBG_STAMP (-1)
#endif
    XcdBarrier bar; bar.bar = (unsigned*)(F.ctl + CW_BAR); bar.x = 0; bar.st = nullptr;
    if (N_LAUNCHES == 1) bar = xcd_barrier_post((unsigned*)(F.ctl + CW_BAR), F.MISC + 8);
#define GRID_BAR() do { if (N_LAUNCHES == 1) { \
        if (DBG_STAMP >= 100 && F.tid == 0) { F.MISC[19] += 1u; if (DBG_STAMP == 100 || DBG_STAMP - 100 == (int)F.MISC[19]) F.MISC[16] = (unsigned)__builtin_amdgcn_s_memrealtime(); } \
        xcd_barrier(bar); \
        if (DBG_STAMP >= 100 && F.tid == 0) { if (DBG_STAMP == 100 || DBG_STAMP - 100 == (int)F.MISC[19]) F.MISC[18] += (unsigned)__builtin_amdgcn_s_memrealtime() - F.MISC[16]; } } } while (0)
    const int lo = args.ph_lo, hi = args.ph_hi;
    if (DBG_STAMP == 200 && F.tid == 0) F.MISC[16] = (unsigned)__builtin_amdgcn_s_memrealtime();
#define STAMP0(k) do { if ((k) == DBG_STAMP && F.tid == 0) F.MISC[16] = (unsigned)__builtin_amdgcn_s_memrealtime(); } while (0)
#define STAMP1(k) do { if ((k) == DBG_STAMP && F.tid == 0) F.MISC[17] = (unsigned)__builtin_amdgcn_s_memrealtime(); } while (0)
#ifndef DBG_STOP
#define DBG_STOP 99
#endif
#define IN(k) (lo <= (k) && (k) < hi && ((k) <= DBG_STOP || (k) == NPH - 1))
#ifndef DBG_REPEAT
#define DBG_REPEAT (-1)
#endif
#define REP(k) _Pragma("unroll") for (int _rep = 0; _rep < ((k) == DBG_REPEAT ? 2 : 1); ++_rep)
#define BOTH(k) (IN(k) && hi > (k) + 1)
    const int bx = (int)blockIdx.x, G = F.G;

#if defined(DBG_GEMMTEST)
    {
        p0_prologue(F); GRID_BAR();
#define GT_ONE(rep) { pg8::Gemm g{(const pg8::bf16_t*)(ws + WS_S0), (const pg8::bf16_t*)(ws + GT_W), TOK, GT_N, DM}; pg8::StaticOrder S; S.init(TOK, GT_N, G, bx); \
          pg8::EpiPlain E{(pg8::bf16_t*)(ws + (256 + 64 * (rep)) * MiB), GT_N}; pg8::gemm_phase<pg8::EpiPlain, pg8::StaticOrder, GT_ALIGN, GT_SP2, GT_F8>(F.lds + RING_OFF, g, S, E); GRID_BAR(); }
        GT_ONE(0) GT_ONE(1) GT_ONE(2) GT_ONE(3)
        { const size_t nw = (size_t)TOK * GT_N / 2, gt = (size_t)(F.vcu * NWAVES + F.wave) * 64 + F.lane, NT = (size_t)G * NWAVES * 64; unsigned cnt = 0;
          const unsigned* o0 = (const unsigned*)(ws + 256 * MiB); const unsigned* o1 = (const unsigned*)(ws + 320 * MiB); const unsigned* o2 = (const unsigned*)(ws + 384 * MiB); const unsigned* o3 = (const unsigned*)(ws + 448 * MiB);
          for (size_t i = gt; i < nw; i += NT) { const unsigned a = o0[i]; cnt += (a != o1[i]) + (a != o2[i]) + (a != o3[i]); }
          if (cnt) atomicAdd((unsigned*)(F.ctl + 2048), cnt);
          GRID_BAR();
          const float r = (float)__hip_atomic_load((unsigned*)(F.ctl + 2048), __ATOMIC_RELAXED, __HIP_MEMORY_SCOPE_AGENT);
          for (size_t i = gt; i < (size_t)TOK * DM; i += NT) F.out[i] = r; }
        return;
    }
#endif
#if defined(DBG_P1TEST)
    {
        p0_prologue(F); GRID_BAR();
#define P1T_RUN(ZUo, QKo, GABo, VTo) { pg8::Gemm g{(const pg8::bf16_t*)(ws + WS_S0), (const pg8::bf16_t*)(ws + WS_WIN), TOK, NIN, DM}; pg8::StaticOrder S; S.init(TOK, NIN, G, bx); \
          pg8::EpiIn E{(pg8::bf16_t*)(ws + (ZUo)), (pg8::bf16_t*)(ws + (ZUo) + 16 * MiB), (pg8::bf16_t*)(ws + (QKo)), (pg8::bf16_t*)(ws + (VTo)), (pg8::bf16_t*)(ws + (GABo)), 0.12751743074602787f  }; \
          pg8::gemm_phase<pg8::EpiIn, pg8::StaticOrder, P1T_ALIGN, P1T_SP2>(F.lds + RING_OFF, g, S, E); GRID_BAR(); }
        P1T_RUN(WS_S1, WS_S2, WS_S4, WS_S6)
        P1T_RUN(96 * MiB, 128 * MiB, 160 * MiB, 432 * MiB)
        { const size_t gt = (size_t)(F.vcu * NWAVES + F.wave) * 64 + F.lane, NT = (size_t)G * NWAVES * 64; unsigned cnt = 0;
#define P1T_CMP(a, b, mib) { const unsigned* pa = (const unsigned*)(ws + (a)); const unsigned* pb = (const unsigned*)(ws + (b)); for (size_t i = gt; i < (size_t)(mib) * MiB / 4; i += NT) cnt += (pa[i] != pb[i]); }
          P1T_CMP(WS_S1, 96 * MiB, 32) P1T_CMP(WS_S2, 128 * MiB, 32) P1T_CMP(WS_S4, 160 * MiB, 64) P1T_CMP(WS_S6, 432 * MiB, 16)
          if (cnt) atomicAdd((unsigned*)(F.ctl + 2048), cnt);
          GRID_BAR();
          const float r = (float)__hip_atomic_load((unsigned*)(F.ctl + 2048), __ATOMIC_RELAXED, __HIP_MEMORY_SCOPE_AGENT);
          for (size_t i = gt; i < (size_t)TOK * DM; i += NT) F.out[i] = r; }
        return;
    }
#endif
    if (IN(0)) REP(0) { STAMP0(0); p0_prologue(F, F.vcu * NWAVES + F.wave, G * NWAVES, G == 256 ? 1 : 3); STAMP1(0); if (BOTH(0)) GRID_BAR(); }

    if (IN(1)) REP(1) { STAMP0(1);
        { pg8::Gemm g{(const pg8::bf16_t*)(ws + WS_S0), (const pg8::bf16_t*)(ws + WS_WIN), TOK, 2048, DM}; pg8::SplitInOrder<false> S; S.S.init(TOK, 2048, G, bx);
          pg8::EpiIn E{(pg8::bf16_t*)(ws + WS_S1), (pg8::bf16_t*)(ws + WS_S1 + 16 * MiB), (pg8::bf16_t*)(ws + WS_S2), (pg8::bf16_t*)(ws + WS_S6), (pg8::bf16_t*)(ws + WS_S4), 0.12751743074602787f  , (float*)(ws + WS_SUBK), 1.0f};
          pg8::gemm_phase<pg8::EpiIn, pg8::SplitInOrder<false>, true, true>(F.lds + RING_OFF, g, S, E); }
        { pg8::Gemm g{(const pg8::bf16_t*)(ws + WS_A0F8), (const pg8::bf16_t*)(ws + WS_WIN8), TOK, 7168, DM / 2}; pg8::SplitInOrder<true> S; S.S.init(TOK, 7168, G, bx);
          pg8::EpiIn E{(pg8::bf16_t*)(ws + WS_S1), (pg8::bf16_t*)(ws + WS_S1 + 16 * MiB), (pg8::bf16_t*)(ws + WS_S2), (pg8::bf16_t*)(ws + WS_S6), (pg8::bf16_t*)(ws + WS_S4), 0.12751743074602787f  , (float*)(ws + WS_SUBK), 1.0f / (16.0f * 256.0f)};
          pg8::gemm_phase<pg8::EpiIn, pg8::SplitInOrder<true>, true, true, true>(F.lds + RING_OFF, g, S, E); }
        { pg8::Gemm g{(const pg8::bf16_t*)(ws + WS_MN8), (const pg8::bf16_t*)(ws + WS_WMKV8), MEMT, 4096, DM / 2}; pg8::ShiftedOrder S; S.init(MEMT, 4096, G, bx, G >= 160 ? 128 : 0);
          pg8::EpiKV E{(pg8::bf16_t*)(ws + WS_KM), 1.0f / (16.0f * 256.0f)};
          pg8::gemm_phase<pg8::EpiKV, pg8::ShiftedOrder, false, true, true>(F.lds + RING_OFF, g, S, E); }
        if (G == 256 && bx >= 160) peer_tables(F, (bx - 160) * NWAVES + F.wave, 96 * NWAVES, 0, TAB1);
        STAMP1(1); if (BOTH(1)) GRID_BAR();
    }

    if (IN(2)) REP(2) { STAMP0(2);
#ifndef DBG_P2DUP
#define DBG_P2DUP 0
#endif
        for (int dup = 0; dup < ((DBG_P2DUP & 1) ? 2 : 1); ++dup)
        for (int u = F.vcu; u < 256; u += G) sg_unit(F, u);
        for (int dup = 0; dup < ((DBG_P2DUP & 2) ? 2 : 1); ++dup)
        for (int u = F.vcu; u < 256; u += G) attn_unit2(F, u);
        __syncthreads();
        if (G == 256 && bx >= 128) p0_prologue(F, (bx - 128) * NWAVES + F.wave, 128 * NWAVES, 2);
        { pg8::Gemm g{(const pg8::bf16_t*)(ws + WS_KM), (const pg8::bf16_t*)(ws + WS_WMQ), 512, DM, 512, 4096, 2048}; pg8::PreOrder<0> S{bx, 0};
          pg8::EpiPre<true> E{(pg8::bf16_t*)(ws + WS_WKT), 2048, 1024, 0, 256, 256, 0, 32.0f};
          pg8::gemm_phase<pg8::EpiPre<true>, pg8::PreOrder<0>, false, true>(F.lds + RING_OFF, g, S, E); }
        { pg8::Gemm g{(const pg8::bf16_t*)(ws + WS_WMO), (const pg8::bf16_t*)(ws + WS_KM), DM, 512, 512, 2048, 4096}; pg8::PreOrder<1> S{bx, 64};
          pg8::EpiPre<true> E{(pg8::bf16_t*)(ws + WS_VWOT), 1024, 256, 2048, 0, 0, 256, 32.0f};
          pg8::gemm_phase<pg8::EpiPre<true>, pg8::PreOrder<1>, false, true>(F.lds + RING_OFF, g, S, E); }
        STAMP1(2); if (BOTH(2)) GRID_BAR();
    }

    if (IN(3)) REP(3) { STAMP0(3);
        { pg8::Gemm g{(const pg8::bf16_t*)(ws + WS_S3), (const pg8::bf16_t*)(ws + WS_WUPA), TOK, DM, 512}; pg8::UpOrder S; S.S.init(TOK, DM, G, bx);
          S.aoff_b = (int)((16 * MiB) / 2); S.boff_b = (int)((WS_WUPB - WS_WUPA) / 2);
          typedef pg8::EpiUp2<WS_S4, WS_S0, WS_S1> EUp; EUp E{ws, 1.0f / (64.0f * 256.0f), 1.0f / (8.0f * 256.0f)};
          pg8::gemm_phase<EUp, pg8::UpOrder, false, true, true>(F.lds + RING_OFF, g, S, E); }
        STAMP1(3); if (BOTH(3)) GRID_BAR();
    }

    if (IN(5)) REP(5) { STAMP0(5);
        pg8::Gemm g{(const pg8::bf16_t*)(ws + WS_S1), (const pg8::bf16_t*)(ws + WS_WOUT), TOK, DM, DM / 2}; pg8::StaticOrder S; S.init(TOK, DM, G, bx);
        pg8::EpiRes<true, false> E{F.in[I_X], (pg8::bf16_t*)(ws + WS_S6), (pg8::bf16_t*)(ws + WS_S0), F.in[I_GMQ], (float*)(ws + WS_PS1), 1.0f / (16.0f * 256.0f), 16.0f};
        pg8::gemm_phase<pg8::EpiRes<true, false>, pg8::StaticOrder, false, true, true>(F.lds + RING_OFF, g, S, E);
        STAMP1(5); if (BOTH(5)) GRID_BAR();
    }

    if (IN(6)) REP(6) { STAMP0(6);
        { pg8::Gemm g{(const pg8::bf16_t*)(ws + WS_S0), (const pg8::bf16_t*)(ws + WS_WKT), TOK, 1024, DM / 2}; pg8::ScoreOrder S{bx};
          pg8::EpiSoftmax E{(const float*)(ws + WS_PS1), (pg8::bf16_t*)(ws + WS_S1), 0.04419417382415922f / (16.0f * 32.0f), EPS, 256.0f};
          pg8::gemm_phase<pg8::EpiSoftmax, pg8::ScoreOrder, false, true, true>(F.lds + RING_OFF, g, S, E); }
        { constexpr int TSPLIT = TAB1 + 1280;
          if (G == 256) { if (bx < 128) peer_tables(F, bx * NWAVES + F.wave, 128 * NWAVES, TAB1, TSPLIT); else peer_tables(F, (bx - 128) * NWAVES + F.wave, 128 * NWAVES, TSPLIT, 2 * 16384); }
          else peer_tables(F, bx * NWAVES + F.wave, G * NWAVES, 0, 2 * 16384); }
        STAMP1(6); if (BOTH(6)) GRID_BAR();
    }

    if (IN(7)) REP(7) { STAMP0(7);
        pg8::Gemm g{(const pg8::bf16_t*)(ws + WS_S1), (const pg8::bf16_t*)(ws + WS_VWOT), TOK, DM, 512}; pg8::BatchOrder S; S.S.init(TOK, DM, G, bx); S.boff_b1 = 2048 * 512;
        pg8::EpiRes<false, true, true> E{(const void*)(ws + WS_S6), (pg8::bf16_t*)(ws + WS_S6), (pg8::bf16_t*)(ws + WS_S0), F.in[I_GFFN], (float*)(ws + WS_PS2), 1.0f / (256.0f * 32.0f), 1.0f};
        pg8::gemm_phase<pg8::EpiRes<false, true, true>, pg8::BatchOrder, false, true, true>(F.lds + RING_OFF, g, S, E);
        STAMP1(7); if (BOTH(7)) GRID_BAR();
    }


    if (IN(9)) REP(9) { STAMP0(9);
        pg8::Gemm g{(const pg8::bf16_t*)(ws + WS_S0), (const pg8::bf16_t*)(ws + WS_WPQ), TOK, DM, DM}; pg8::StaticOrder S; S.init(TOK, DM, G, bx);
        pg8::EpiScore E{(const float*)(ws + WS_PS2), (float*)(ws + WS_S2), EPS};
        pg8::gemm_phase<pg8::EpiScore, pg8::StaticOrder, false, true>(F.lds + RING_OFF, g, S, E);
        { pg8::Unit u; for (int i = 0; S.next(i, u); ++i) route_block(F, u.pn * 256 + u.pm * 8 + F.wave); }
        STAMP1(9); if (BOTH(9)) GRID_BAR();
    }


    if (IN(12)) REP(12) { STAMP0(12);
        const int gw = F.vcu * NWAVES + F.wave, NGW = G * NWAVES;
#if defined(DBG_PROBE)
        { const bf16* src = (const bf16*)(ws + DBG_PROBE_OFF);
          for (int t = gw; t < TOK; t += NGW) for (int c = F.lane; c < DM; c += 64) F.out[(size_t)t * DM + c] = bflo((unsigned)src[(size_t)t * DBG_PROBE_PITCH + (c % DBG_PROBE_PITCH)]); }
#elif defined(DBG_PROBE_P1)
        { const bf16* QKp = (const bf16*)(ws + WS_S2); const bf16* VTp = (const bf16*)(ws + WS_S6); const bf16* ZUp = (const bf16*)(ws + WS_S1); const bf16* ZVp = (const bf16*)(ws + WS_S1 + 16 * MiB); const bf16* GABp = (const bf16*)(ws + WS_S4);
          const bf16* KMp = (const bf16*)(ws + WS_KM);
          for (int t = gw; t < TOK; t += NGW) for (int c = F.lane; c < DM; c += 64) { float v = 0.f;
            if (DBG_PROBE_P1 & 1) v += bflo((unsigned)QKp[(size_t)t * 2048 + c]);
            if (DBG_PROBE_P1 & 2) v += bflo((unsigned)VTp[(size_t)t * 1024 + (c & 1023)]);
            if (DBG_PROBE_P1 & 4) v += bflo((unsigned)ZUp[(size_t)t * 1024 + (c & 1023)]);
            if (DBG_PROBE_P1 & 256) v += bflo((unsigned)ZVp[(size_t)t * 1024 + (c & 1023)]);
            if (DBG_PROBE_P1 & 8) v += bflo((unsigned)GABp[(size_t)t * 4096 + c]) + bflo((unsigned)GABp[(size_t)t * 4096 + 2048 + c]);
            if (DBG_PROBE_P1 & 16) v += bflo((unsigned)KMp[(size_t)(t & 1023) * 2048 + c]);
            if (DBG_PROBE_P1 & 32) v += bflo((unsigned)((const bf16*)(ws + WS_S0))[(size_t)t * 2048 + c]);
            if (DBG_PROBE_P1 & 64) v += bflo((unsigned)((const bf16*)(ws + WS_WIN))[(size_t)t * 2048 + c]);
            if (DBG_PROBE_P1 & 128) v += bflo((unsigned)((const bf16*)(ws + WS_MN))[(size_t)(t & 511) * 2048 + c]) + bflo((unsigned)((const bf16*)(ws + WS_WMKV))[(size_t)(t & 4095) * 2048 + c]);
            F.out[(size_t)t * DM + c] = v; } }
#else
        __syncthreads();
        if (gw + NGW < TOK) peer_pair3<false>(F, gw, gw + NGW);
        if (gw + 3 * NGW < TOK) peer_pair3<true>(F, gw + 2 * NGW, gw + 3 * NGW);
#endif
        if (DBG_REPEAT == NPH - 1) GRID_BAR();
        STAMP1(12);
    }
#undef IN
#undef BOTH
    if (DBG_STAMP == 200) { GRID_BAR(); if (F.tid == 0) F.MISC[17] = (unsigned)__builtin_amdgcn_s_memrealtime(); }
    if (DBG_STAMP >= 0) { __syncthreads(); if (blockIdx.x == 0 && threadIdx.x == 0) { asm volatile("s_waitcnt vmcnt(0)" ::: "memory"); args.out[0] = (DBG_STAMP == 200 ? (float)(F.MISC[17] - F.MISC[16]) * 0.000625f : (DBG_STAMP >= 100 ? (float)F.MISC[18] : (float)(F.MISC[17] - F.MISC[16])) * 0.005f); } }
}

extern "C" void kernel_launch(void* const* d_in, const int* in_sizes, int n_in, void* d_out, int out_size, void* d_ws, size_t ws_size, hipStream_t stream) {
    static int grid = 0;
    if (grid == 0) {
        if (n_in != 23 || out_size != TOK * DM || ws_size < WS_END) { fprintf(stderr, "kernel_launch: unexpected shapes (n_in %d, out %d, ws %zu)\n", n_in, out_size, ws_size); grid = -1; return; }
        int dev = 0, cus = 0, per_cu = 0;
        if (hipGetDevice(&dev) != hipSuccess || hipDeviceGetAttribute(&cus, hipDeviceAttributeMultiprocessorCount, dev) != hipSuccess) { grid = -1; return; }
        if (hipFuncSetAttribute((const void*)mk_fwd, hipFuncAttributeMaxDynamicSharedMemorySize, LDS_BYTES) != hipSuccess) { fprintf(stderr, "kernel_launch: hipFuncSetAttribute failed\n"); grid = -1; return; }
        if (hipOccupancyMaxActiveBlocksPerMultiprocessor(&per_cu, (const void*)mk_fwd, NWAVES * 64, LDS_BYTES) != hipSuccess || per_cu < 1) { fprintf(stderr, "kernel_launch: occupancy query reports %d blocks per CU\n", per_cu); }
        (void)hipGetLastError();
        grid = cus;
    }
    if (grid < 0) return;
    if (hipMemsetAsync((char*)d_ws + WS_CTL, 0, CTL_ZERO_BYTES, stream) != hipSuccess) return;
    Args a{};
    for (int i = 0; i < 23; ++i) a.in[i] = (const float*)d_in[i];
    a.out = (float*)d_out; a.ws = (unsigned char*)d_ws; a.pad = 0;
    for (int li = 0; li < N_LAUNCHES; ++li) {
        a.ph_lo = (N_LAUNCHES == 1) ? 0 : li; a.ph_hi = (N_LAUNCHES == 1) ? NPH : li + 1; a.li = li;
        hipLaunchKernelGGL(mk_fwd, dim3(grid), dim3(NWAVES * 64), LDS_BYTES, stream, a);
        if (hipPeekAtLastError() != hipSuccess) { fprintf(stderr, "kernel_launch: launch %d failed\n", li); break; }
    }
}
```
